# Optimizing an MI355X kernel written in HIP

```python
import math
import jax, jax.numpy as jnp
from jax import lax
import numpy as np

D_MODEL = 1024
BATCH = 4
SEQ = 4096
DEPTH = 1

D_MIX = D_MODEL
D_REC = D_MIX // 2
REC_BLOCKS = 8
REC_BLOCK_DIM = D_REC // REC_BLOCKS
CONV_WIDTH = 4
RG_C = 8.0
N_ATT_HEADS = 4
ATT_HALF_DIM = 64
ATT_V_DIM = 2 * ATT_HALF_DIM
D_ATT = N_ATT_HEADS * ATT_V_DIM
D_QK = N_ATT_HEADS * 2 * ATT_HALF_DIM
D_IN = 2 * D_REC + 2 * D_QK + D_ATT
ROPE_DIM = ATT_HALF_DIM // 4
ROPE_THETA = 500000.0
Q_BLOCK = 128
N_EXPERTS = 64
TOP_K = 8
N_GROUPS = 8
TOPK_GROUPS = 4
D_EXPERT = 256
D_SHARED = 256
ROUTE_SCALE = 2.5
MOE_BLOCK = 128
D_PLE = 256
EPS = 1e-6

kernel_name = "hymba_rglru_diffattn_moe_ple"


def rms_norm(x, g):
    xf = x.astype(jnp.float32)
    y = xf * lax.rsqrt(jnp.mean(xf * xf, axis=-1, keepdims=True) + EPS)
    return (y * g.astype(jnp.float32)).astype(x.dtype)


def rope_tables(positions):
    inv_freq = ROPE_THETA ** (-jnp.arange(0, ROPE_DIM, 2, dtype=jnp.float32) / ROPE_DIM)
    ang = positions.astype(jnp.float32)[..., None] * inv_freq
    return jnp.cos(ang), jnp.sin(ang)


def partial_rope(x, cos, sin):
    half = ROPE_DIM // 2
    c = cos[:, :, None, None, :]
    s = sin[:, :, None, None, :]
    xf = x.astype(jnp.float32)
    x1 = xf[..., :half]
    x2 = xf[..., half:ROPE_DIM]
    out = jnp.concatenate([x1 * c - x2 * s, x2 * c + x1 * s, xf[..., ROPE_DIM:]], axis=-1)
    return out.astype(x.dtype)


def rglru_mixer(xr, gate, conv_w, conv_b, w_a, b_a, w_i, b_i, rg_lambda):
    B, S, _ = xr.shape
    xc = lax.conv_general_dilated(
        xr, conv_w[:, None, :], window_strides=(1,), padding=[(CONV_WIDTH - 1, 0)],
        dimension_numbers=("NWC", "WIO", "NWC"), feature_group_count=D_REC) + conv_b
    xb = xc.reshape(B, S, REC_BLOCKS, REC_BLOCK_DIM)
    r = jax.nn.sigmoid(jnp.einsum("bsgi,gij->bsgj", xb, w_a) + b_a).reshape(B, S, D_REC)
    i = jax.nn.sigmoid(jnp.einsum("bsgi,gij->bsgj", xb, w_i) + b_i).reshape(B, S, D_REC)
    log_a = -RG_C * r.astype(jnp.float32) * jax.nn.softplus(-rg_lambda.astype(jnp.float32))
    a = jnp.exp(log_a)
    mult = jnp.sqrt(-jnp.expm1(2.0 * log_a))
    u = mult * i.astype(jnp.float32) * xc.astype(jnp.float32)

    def combine(left, right):
        a1, b1 = left
        a2, b2 = right
        return a1 * a2, a2 * b1 + b2

    _, h = lax.associative_scan(combine, (a, u), axis=1)
    y = h * jax.nn.gelu(gate.astype(jnp.float32))
    return y.astype(xr.dtype)


def diff_attention(q, k, v, cos, sin, lq1, lk1, lq2, lk2, g_sub, lam_init):
    B, S, _ = q.shape
    H, dh = N_ATT_HEADS, ATT_HALF_DIM
    q = partial_rope(q.reshape(B, S, H, 2, dh), cos, sin)
    k = partial_rope(k.reshape(B, S, H, 2, dh), cos, sin)
    v = v.reshape(B, S, H, ATT_V_DIM)
    f32 = jnp.float32
    lam = (jnp.exp(jnp.sum(lq1.astype(f32) * lk1.astype(f32)))
           - jnp.exp(jnp.sum(lq2.astype(f32) * lk2.astype(f32))) + lam_init)
    kh = k.transpose(0, 2, 3, 1, 4)
    vh = v.transpose(0, 2, 1, 3)
    nb = S // Q_BLOCK
    qb = q.transpose(0, 2, 3, 1, 4).reshape(B, H, 2, nb, Q_BLOCK, dh).transpose(3, 0, 1, 2, 4, 5)
    k_pos = jnp.arange(S)
    scale = dh ** -0.5

    def block(args):
        qblk, bi = args
        s = jnp.einsum("bhcqd,bhckd->bhcqk", qblk, kh).astype(f32) * scale
        q_pos = bi * Q_BLOCK + jnp.arange(Q_BLOCK)
        mask = k_pos[None, :] <= q_pos[:, None]
        s = jnp.where(mask, s, -jnp.inf)
        pr = jax.nn.softmax(s, axis=-1)
        w = pr[:, :, 0] - lam * pr[:, :, 1]
        return jnp.einsum("bhqk,bhkd->bhqd", w.astype(vh.dtype), vh)

    o = lax.map(block, (qb, jnp.arange(nb)))
    o = o.transpose(1, 0, 3, 2, 4).reshape(B, S, H, ATT_V_DIM)
    o = rms_norm(o, g_sub) * (1.0 - lam_init)
    return o.reshape(B, S, D_ATT)


def moe_ffn(h, w_router, e_bias, w1, w3, w2, ws1, ws3, ws2):
    B, S, D = h.shape
    T = B * S
    E, K, M = N_EXPERTS, TOP_K, MOE_BLOCK
    hf = h.reshape(T, D)
    scores = jax.nn.sigmoid((hf @ w_router).astype(jnp.float32))
    sel = scores + e_bias.astype(jnp.float32)
    grp = sel.reshape(T, N_GROUPS, E // N_GROUPS)
    grp_score = lax.top_k(grp, 2)[0].sum(-1)
    _, top_groups = lax.top_k(grp_score, TOPK_GROUPS)
    gmask = jax.nn.one_hot(top_groups, N_GROUPS).sum(1) > 0
    sel = jnp.where(jnp.repeat(gmask, E // N_GROUPS, axis=-1), sel, -jnp.inf)
    _, topi = lax.top_k(sel, K)
    topw = jnp.take_along_axis(scores, topi, axis=-1)
    topw = topw / jnp.sum(topw, axis=-1, keepdims=True) * ROUTE_SCALE
    N = T * K
    e_flat = topi.reshape(N).astype(jnp.int32)
    t_flat = jnp.repeat(jnp.arange(T, dtype=jnp.int32), K)
    w_flat = topw.reshape(N)
    order = jnp.argsort(e_flat)
    e_sorted = e_flat[order]
    t_sorted = t_flat[order]
    w_sorted = w_flat[order]
    counts = jnp.bincount(e_flat, length=E).astype(jnp.int32)
    padded = (counts + M - 1) // M * M
    pad_end = jnp.cumsum(padded)
    pad_start = pad_end - padded
    start = jnp.cumsum(counts) - counts
    dest = pad_start[e_sorted] + jnp.arange(N, dtype=jnp.int32) - start[e_sorted]
    P = N + E * M
    nblk = P // M
    row_token = jnp.zeros((P,), jnp.int32).at[dest].set(t_sorted)
    xbuf = hf[row_token].reshape(nblk, M, D)
    blk_expert = jnp.minimum(
        jnp.searchsorted(pad_end, jnp.arange(nblk, dtype=jnp.int32) * M, side="right"), E - 1)

    def expert_block(args):
        xb, e = args
        return (jax.nn.silu(xb @ w1[e]) * (xb @ w3[e])) @ w2[e]

    ybuf = lax.map(expert_block, (xbuf, blk_expert)).reshape(P, D)
    y_routed = jax.ops.segment_sum(ybuf[dest] * w_sorted[:, None].astype(ybuf.dtype),
                                   t_sorted, num_segments=T)
    y_shared = (jax.nn.silu(hf @ ws1) * (hf @ ws3)) @ ws2
    return (y_routed + y_shared).reshape(B, S, D)


def setup_inputs(seed: int = 0) -> dict:
    key = jax.random.key(seed)
    ks = jax.random.split(key, 32)
    L, D, E, F = DEPTH, D_MODEL, N_EXPERTS, D_EXPERT
    nrm = lambda k, shp, s: jax.random.normal(k, shp, jnp.float32) * s
    gain = lambda k, shp: 1.0 + 0.02 * jax.random.normal(k, shp, jnp.float32)
    a0 = jax.random.uniform(ks[9], (L, D_REC), jnp.float32, 0.9, 0.999)
    s0 = a0 ** (1.0 / RG_C)
    rg_lambda = jnp.log(s0) - jnp.log1p(-s0)
    return {
        "x": nrm(ks[0], (BATCH, SEQ, D), 1.0),
        "p": nrm(ks[1], (DEPTH, BATCH, SEQ, D_PLE), 1.0),
        "positions": jnp.broadcast_to(jnp.arange(SEQ, dtype=jnp.int32)[None, :], (BATCH, SEQ)),
        "ln_mix": gain(ks[2], (L, D)),
        "w_in": nrm(ks[3], (L, D, D_IN), D ** -0.5),
        "conv_w": nrm(ks[4], (L, CONV_WIDTH, D_REC), CONV_WIDTH ** -0.5),
        "conv_b": nrm(ks[5], (L, D_REC), 0.01),
        "w_a": nrm(ks[6], (L, REC_BLOCKS, REC_BLOCK_DIM, REC_BLOCK_DIM), REC_BLOCK_DIM ** -0.5),
        "b_a": nrm(ks[7], (L, REC_BLOCKS, REC_BLOCK_DIM), 0.01),
        "w_i": nrm(ks[8], (L, REC_BLOCKS, REC_BLOCK_DIM, REC_BLOCK_DIM), REC_BLOCK_DIM ** -0.5),
        "b_i": nrm(ks[10], (L, REC_BLOCKS, REC_BLOCK_DIM), 0.01),
        "rg_lambda": rg_lambda,
        "g_rec": gain(ks[11], (L, D_REC)),
        "lq1": nrm(ks[12], (L, ATT_HALF_DIM), 0.1),
        "lk1": nrm(ks[13], (L, ATT_HALF_DIM), 0.1),
        "lq2": nrm(ks[14], (L, ATT_HALF_DIM), 0.1),
        "lk2": nrm(ks[15], (L, ATT_HALF_DIM), 0.1),
        "g_sub": gain(ks[16], (L, ATT_V_DIM)),
        "w_out": nrm(ks[17], (L, D_MIX, D), D_MIX ** -0.5),
        "ln_moe": gain(ks[18], (L, D)),
        "w_router": nrm(ks[19], (L, D, E), D ** -0.5),
        "e_bias": nrm(ks[20], (L, E), 0.01),
        "w1": nrm(ks[21], (L, E, D, F), D ** -0.5),
        "w3": nrm(ks[22], (L, E, D, F), D ** -0.5),
        "w2": nrm(ks[23], (L, E, F, D), F ** -0.5),
        "ws1": nrm(ks[24], (L, D, D_SHARED), D ** -0.5),
        "ws3": nrm(ks[25], (L, D, D_SHARED), D ** -0.5),
        "ws2": nrm(ks[26], (L, D_SHARED, D), D_SHARED ** -0.5),
        "ln_ple": gain(ks[27], (L, D)),
        "w_ple_gate": nrm(ks[28], (L, D, D), D ** -0.5),
        "w_ple_proj": nrm(ks[29], (L, D_PLE, D), D_PLE ** -0.5),
        "ln_f": gain(ks[30], (D,)),
    }


def reference(x, p, positions, ln_mix, w_in, conv_w, conv_b, w_a, b_a, w_i, b_i, rg_lambda,
              g_rec, lq1, lk1, lq2, lk2, g_sub, w_out, ln_moe, w_router, e_bias, w1, w3, w2,
              ws1, ws3, ws2, ln_ple, w_ple_gate, w_ple_proj, ln_f):
    cos, sin = rope_tables(positions)
    h = x
    splits = [D_REC, 2 * D_REC, 2 * D_REC + D_QK, 2 * D_REC + 2 * D_QK]
    for l in range(DEPTH):
        lam_init = 0.8 - 0.6 * math.exp(-0.3 * l)
        hn = rms_norm(h, ln_mix[l])
        z = hn @ w_in[l]
        xr, gate, q, k, v = jnp.split(z, splits, axis=-1)
        y_rec = rms_norm(rglru_mixer(xr, gate, conv_w[l], conv_b[l], w_a[l], b_a[l],
                                     w_i[l], b_i[l], rg_lambda[l]), g_rec[l])
        y_att = diff_attention(q, k, v, cos, sin, lq1[l], lk1[l], lq2[l], lk2[l], g_sub[l], lam_init)
        h = h + jnp.concatenate([y_rec, y_att], axis=-1) @ w_out[l]
        h = h + moe_ffn(rms_norm(h, ln_moe[l]), w_router[l], e_bias[l], w1[l], w3[l], w2[l],
                        ws1[l], ws3[l], ws2[l])
        ple_gate = jax.nn.sigmoid(rms_norm(h, ln_ple[l]) @ w_ple_gate[l])
        h = h + ple_gate * (p[l] @ w_ple_proj[l])
    return rms_norm(h, ln_f)
```

```cpp
#include <hip/hip_runtime.h>
#include <stdint.h>
#include <math.h>

typedef unsigned short bf16;
typedef unsigned u32x4 __attribute__((ext_vector_type(4)));

constexpr int T = 16384, SEQ = 4096, NBATCH = 4, D = 1024, DIN = 2560, NE = 64, FE = 256, DPLE = 256;
constexpr int ECAP = 16384;
constexpr float EPS = 1e-6f;
constexpr float LAM_INIT = 0.2f;
constexpr float YSCALE = 16.f;

constexpr size_t MiB = 1u << 20;
constexpr size_t WS_CTL = 0;
constexpr size_t WS_ROPE = 1 * MiB;
constexpr size_t WS_SS = 2 * MiB;
constexpr size_t WS_TOPW = 3 * MiB;
constexpr size_t WS_TOPD = 3 * MiB + 512 * 1024;
constexpr size_t WS_ROWTOK = 4 * MiB;
constexpr size_t WS_WOUT = 8 * MiB;
constexpr size_t WS_WPG = 10 * MiB;
constexpr size_t WS_WPP = 12 * MiB;
constexpr size_t WS_WIN = 13 * MiB;
constexpr size_t WS_W2 = 18 * MiB;
constexpr size_t WS_W13 = 51 * MiB;
constexpr size_t WS_XB = 116 * MiB;
constexpr size_t WS_MIX = 116 * MiB;
constexpr size_t WS_ZA = 148 * MiB;
constexpr size_t WS_H1B = 148 * MiB;
constexpr size_t WS_Q = 180 * MiB, WS_K = 196 * MiB, WS_V = 212 * MiB;
constexpr size_t WS_O = 228 * MiB;
constexpr size_t WS_ACT = 180 * MiB;
constexpr size_t WS_YB = 51 * MiB;
constexpr size_t WS_H2B = 180 * MiB;
constexpr size_t WS_PB = 212 * MiB;
constexpr size_t WS_G = 220 * MiB;
constexpr size_t WS_END = 260 * MiB;

__device__ __forceinline__ float bf2f(bf16 v) { return __uint_as_float(((unsigned)v) << 16); }
__device__ __forceinline__ bf16 f2bf(float f) { unsigned u = __float_as_uint(f); return (bf16)((u + 0x7fffu + ((u >> 16) & 1u)) >> 16); }
__device__ __forceinline__ unsigned char f2fp8(float v) { int r = __builtin_amdgcn_cvt_pk_fp8_f32(v, v, 0, false); return (unsigned char)(r & 0xff); }
__device__ __forceinline__ float fp82f(unsigned char b) { return __builtin_amdgcn_cvt_f32_fp8((int)b, 0); }
__device__ __forceinline__ float wave_sum(float v) {
#pragma unroll
    for (int o = 1; o < 64; o <<= 1) v += __shfl_xor(v, o);
    return v;
}
__device__ __forceinline__ float sigmoidf_(float x) { return 1.f / (1.f + __expf(-x)); }
__device__ __forceinline__ float gelu_tanh(float x) { const float c = 0.7978845608028654f; float t = tanhf(c * (x + 0.044715f * x * x * x)); return 0.5f * x * (1.f + t); }

__global__ void __launch_bounds__(256) k_wconv(const float* W, int K, int N, const float* gain, bf16* out, int rowmode, int sel, size_t in_stride, size_t out_stride) {
    __shared__ float tile[32][33];
    const float* Wm = W + (size_t)blockIdx.z * in_stride; bf16* om = out + (size_t)blockIdx.z * out_stride;
    const int n0 = blockIdx.x * 32, k0 = blockIdx.y * 32, tx = threadIdx.x & 31, ty = threadIdx.x >> 5;
#pragma unroll
    for (int i = 0; i < 4; ++i) { const int k = k0 + ty + 8 * i; tile[ty + 8 * i][tx] = Wm[(size_t)k * N + n0 + tx] * (gain ? gain[k] : 1.f); }
    __syncthreads();
#pragma unroll
    for (int i = 0; i < 4; ++i) { const int n = n0 + ty + 8 * i; const int row = rowmode ? ((n >> 7) * 256 + sel * 128 + (n & 127)) : n;
        om[(size_t)row * K + k0 + tx] = f2bf(tile[tx][ty + 8 * i]); }
}
__global__ void __launch_bounds__(256) k_xnorm(const float* x, bf16* xb) {
    const int row = blockIdx.x * 4 + (threadIdx.x >> 6), lane = threadIdx.x & 63;
    const float* xr = x + (size_t)row * D; float v[16]; float s = 0.f;
#pragma unroll
    for (int j = 0; j < 16; ++j) { v[j] = xr[lane + 64 * j]; s += v[j] * v[j]; }
    const float rstd = rsqrtf(wave_sum(s) * (1.f / D) + EPS);
#pragma unroll
    for (int j = 0; j < 16; ++j) xb[(size_t)row * D + lane + 64 * j] = f2bf(v[j] * rstd);
}
__global__ void __launch_bounds__(256) k_rope_table(const int* pos, float* cs) {
    const int i = blockIdx.x * 256 + threadIdx.x;
    const int t = i >> 3, f = i & 7;
    const float inv = powf(500000.f, -(float)f / 8.f);
    const float ang = (float)pos[t] * inv;
    cs[t * 16 + f] = cosf(ang); cs[t * 16 + 8 + f] = sinf(ang);
}
__global__ void __launch_bounds__(256) k_cvt_bf16(const float* in, bf16* out, int n) { const int i = blockIdx.x * 256 + threadIdx.x; if (i < n) out[i] = f2bf(in[i]); }

template <class Epi>
__device__ __forceinline__ void ngemm_tile(const bf16* A, int lda, const int* rowidx, int row0, int nvalid  , const bf16* Bt, const bf16* B2, int ldb, int col0, int K, const Epi& epi) {
    __shared__ float sA[32][68]; __shared__ float sB[32][68]; __shared__ float sB2[32][68];
    const int tid = threadIdx.x, lr = tid >> 2, ks = (tid & 3) * 8, ty = tid >> 4, tx = tid & 15;
    int arow = row0 + lr; if (arow >= nvalid) arow = nvalid - 1;
    const size_t ar = rowidx ? (size_t)rowidx[arow] : (size_t)arow;
    const bf16* ap = A + ar * lda + ks; const bf16* bp = Bt + (size_t)(col0 + lr) * ldb + ks; const bf16* bp2 = B2 ? B2 + (size_t)(col0 + lr) * ldb + ks : nullptr;
    float acc[4][4], acc2[4][4];
#pragma unroll
    for (int i = 0; i < 4; ++i)
#pragma unroll
        for (int j = 0; j < 4; ++j) { acc[i][j] = 0.f; acc2[i][j] = 0.f; }
    for (int k0 = 0; k0 < K; k0 += 32) {
        const u32x4 av = *(const u32x4*)(ap + k0), bv = *(const u32x4*)(bp + k0);
        u32x4 bv2 = (u32x4){0u, 0u, 0u, 0u}; if (B2) bv2 = *(const u32x4*)(bp2 + k0);
        __syncthreads();
#pragma unroll
        for (int i = 0; i < 4; ++i) {
            sA[ks + 2 * i][lr] = __uint_as_float(av[i] << 16); sA[ks + 2 * i + 1][lr] = __uint_as_float(av[i] & 0xffff0000u);
            sB[ks + 2 * i][lr] = __uint_as_float(bv[i] << 16); sB[ks + 2 * i + 1][lr] = __uint_as_float(bv[i] & 0xffff0000u);
            if (B2) { sB2[ks + 2 * i][lr] = __uint_as_float(bv2[i] << 16); sB2[ks + 2 * i + 1][lr] = __uint_as_float(bv2[i] & 0xffff0000u); }
        }
        __syncthreads();
#pragma unroll 8
        for (int k = 0; k < 32; ++k) {
            float a[4], b[4], b2[4];
#pragma unroll
            for (int i = 0; i < 4; ++i) { a[i] = sA[k][ty * 4 + i]; b[i] = sB[k][tx * 4 + i]; b2[i] = B2 ? sB2[k][tx * 4 + i] : 0.f; }
#pragma unroll
            for (int i = 0; i < 4; ++i)
#pragma unroll
                for (int j = 0; j < 4; ++j) { acc[i][j] += a[i] * b[j]; if (B2) acc2[i][j] += a[i] * b2[j]; }
        }
    }
#pragma unroll
    for (int i = 0; i < 4; ++i) { const int r = row0 + ty * 4 + i; if (r < nvalid) {
#pragma unroll
            for (int j = 0; j < 4; ++j) epi(r, col0 + tx * 4 + j, acc[i][j], acc2[i][j]); } }
}

struct Epi1 { bf16 *za, *q, *k, *v;
    __device__ void operator()(int r, int c, float a, float) const {
        if (c < 1024) za[(size_t)r * 1024 + c] = f2bf(a);
        else if (c < 1536) q[(size_t)r * 512 + (c - 1024)] = f2bf(a);
        else if (c < 2048) k[(size_t)r * 512 + (c - 1536)] = f2bf(a);
        else v[(size_t)r * 512 + (c - 2048)] = f2bf(a); } };
__global__ void __launch_bounds__(256) k_gemm1(const bf16* xb, const bf16* wint, Epi1 e) { ngemm_tile(xb, D, nullptr, blockIdx.y * 64, T, wint, nullptr, D, blockIdx.x * 64, D, e); }

constexpr float C2 = 0.125f * 1.4426950408889634f;
__global__ void __launch_bounds__(256) k_rope(bf16* q, bf16* k, const float* cs) {
    const int i = blockIdx.x * 256 + threadIdx.x;
    const int t = i >> 8, hc = (i >> 5) & 7, j = i & 31;
    bf16* qp = q + (size_t)t * 512 + hc * 64; bf16* kp = k + (size_t)t * 512 + hc * 64;
    if (j < 8) {
        const float c = cs[t * 16 + j], s = cs[t * 16 + 8 + j];
        const float q1 = bf2f(qp[j]), q2 = bf2f(qp[j + 8]), k1 = bf2f(kp[j]), k2 = bf2f(kp[j + 8]);
        qp[j] = f2bf((q1 * c - q2 * s) * C2); qp[j + 8] = f2bf((q2 * c + q1 * s) * C2);
        kp[j] = f2bf(k1 * c - k2 * s); kp[j + 8] = f2bf(k2 * c + k1 * s);
    } else { const int d = 16 + 2 * (j - 8); qp[d] = f2bf(bf2f(qp[d]) * C2); qp[d + 1] = f2bf(bf2f(qp[d + 1]) * C2); }
}

__global__ void __launch_bounds__(256) k_attn(const bf16* Q, const bf16* K, const bf16* V, bf16* O) {
    const int lane = threadIdx.x & 63, w = threadIdx.x >> 6;
    const int gid = blockIdx.x * 4 + w;
    const int vh = gid & 15, row = gid >> 4, b = row / SEQ, t = row % SEQ;
    const int hc = vh >> 1, h = vh >> 2, vhalf = vh & 1;
    float q[64];
    { const bf16* qp = Q + (size_t)row * 512 + hc * 64;
#pragma unroll
      for (int d = 0; d < 64; ++d) q[d] = bf2f(qp[d]); }
    float m = -INFINITY, l = 0.f, o[64];
#pragma unroll
    for (int d = 0; d < 64; ++d) o[d] = 0.f;
    for (int j = lane; j <= t; j += 64) {
        const size_t kr = (size_t)(b * SEQ + j);
        const bf16* kp = K + kr * 512 + hc * 64; const bf16* vp = V + kr * 512 + h * 128 + vhalf * 64;
        float s = 0.f;
#pragma unroll
        for (int d = 0; d < 64; ++d) s += q[d] * bf2f(kp[d]);
        const float mn = fmaxf(m, s), f = exp2f(m - mn), p = exp2f(s - mn);
        l = l * f + p;
#pragma unroll
        for (int d = 0; d < 64; ++d) o[d] = o[d] * f + p * bf2f(vp[d]);
        m = mn;
    }
    float M = m;
#pragma unroll
    for (int off = 1; off < 64; off <<= 1) M = fmaxf(M, __shfl_xor(M, off));
    const float sc = (m == -INFINITY) ? 0.f : exp2f(m - M);
    const float L = wave_sum(l * sc);
    bf16* op = O + (size_t)row * 1024 + vh * 64;
#pragma unroll
    for (int d = 0; d < 64; ++d) { const float vsum = wave_sum(o[d] * sc); if (lane == (d & 63)) op[d] = f2bf(vsum / L); }
}

__global__ void __launch_bounds__(64) k_rglru(const bf16* za, const float* conv_w, const float* conv_b, const float* w_a, const float* b_a, const float* w_i, const float* b_i,
                                              const float* rg_lambda, bf16* mix) {
    __shared__ float sx[64];
    const int b = blockIdx.x >> 3, g = blockIdx.x & 7, j = threadIdx.x, ch = g * 64 + j;
    float wa[64], wi[64];
#pragma unroll
    for (int i = 0; i < 64; ++i) { wa[i] = w_a[(size_t)(g * 64 + i) * 64 + j]; wi[i] = w_i[(size_t)(g * 64 + i) * 64 + j]; }
    const float cw0 = conv_w[0 * 512 + ch], cw1 = conv_w[1 * 512 + ch], cw2 = conv_w[2 * 512 + ch], cw3 = conv_w[3 * 512 + ch], cb = conv_b[ch];
    const float ba = b_a[ch], bi = b_i[ch];
    const float lam = rg_lambda[ch]; const float sp = log1pf(expf(-lam));
    float x0 = 0.f, x1 = 0.f, x2 = 0.f, h = 0.f;
    for (int t = 0; t < SEQ; ++t) {
        const size_t row = (size_t)b * SEQ + t;
        const float xr = bf2f(za[row * 1024 + ch]), gate = bf2f(za[row * 1024 + 512 + ch]);
        const float xc = cw0 * x0 + cw1 * x1 + cw2 * x2 + cw3 * xr + cb;
        x0 = x1; x1 = x2; x2 = xr;
        __syncthreads(); sx[j] = xc; __syncthreads();
        float ra = ba, ri = bi;
#pragma unroll
        for (int i = 0; i < 64; ++i) { const float xv = sx[i]; ra += xv * wa[i]; ri += xv * wi[i]; }
        const float r = sigmoidf_(ra), ig = sigmoidf_(ri);
        const float log_a = -8.f * r * sp; const float a = expf(log_a); const float mult = sqrtf(-expm1f(2.f * log_a));
        h = a * h + mult * ig * xc;
        mix[row * 1024 + ch] = f2bf(h * gelu_tanh(gate));
    }
}
__global__ void __launch_bounds__(256) k_recnorm(bf16* mix, const float* g_rec) {
    const int row = blockIdx.x * 4 + (threadIdx.x >> 6), lane = threadIdx.x & 63;
    bf16* p = mix + (size_t)row * 1024; float v[8]; float s = 0.f;
#pragma unroll
    for (int j = 0; j < 8; ++j) { v[j] = bf2f(p[lane + 64 * j]); s += v[j] * v[j]; }
    const float rstd = rsqrtf(wave_sum(s) * (1.f / 512.f) + EPS);
#pragma unroll
    for (int j = 0; j < 8; ++j) p[lane + 64 * j] = f2bf(v[j] * rstd * g_rec[lane + 64 * j]);
}
__global__ void __launch_bounds__(256) k_attmix(const bf16* O, const float* lq1, const float* lk1, const float* lq2, const float* lk2, const float* g_sub, bf16* mix) {
    const int row = blockIdx.x * 4 + (threadIdx.x >> 6), lane = threadIdx.x & 63;
    float s1 = lq1[lane] * lk1[lane], s2 = lq2[lane] * lk2[lane];
    s1 = wave_sum(s1); s2 = wave_sum(s2);
    const float lam = expf(s1) - expf(s2) + LAM_INIT;
    const bf16* op = O + (size_t)row * 1024;
    const int h = lane >> 4, e0 = (lane & 15) * 8, vhalf = e0 >> 6, d0 = e0 & 63;
    float y[8]; float s = 0.f;
#pragma unroll
    for (int i = 0; i < 8; ++i) { const float o1 = bf2f(op[(h * 4 + 0 * 2 + vhalf) * 64 + d0 + i]), o2 = bf2f(op[(h * 4 + 1 * 2 + vhalf) * 64 + d0 + i]); y[i] = o1 - lam * o2; s += y[i] * y[i]; }
    s += __shfl_xor(s, 1); s += __shfl_xor(s, 2); s += __shfl_xor(s, 4); s += __shfl_xor(s, 8);
    const float rstd = rsqrtf(s * (1.f / 128.f) + EPS);
#pragma unroll
    for (int i = 0; i < 8; ++i) mix[(size_t)row * 1024 + 512 + h * 128 + e0 + i] = f2bf(y[i] * rstd * g_sub[e0 + i] * (1.f - LAM_INIT));
}

struct EpiOut { const float* x; float* out; bf16* hb;
    __device__ void operator()(int r, int c, float a, float) const { const size_t i = (size_t)r * D + c; const float h = x[i] + a; out[i] = h; hb[i] = f2bf(h); } };
__global__ void __launch_bounds__(256) k_gemm_out(const bf16* mix, const bf16* wt, EpiOut e) { ngemm_tile(mix, D, nullptr, blockIdx.y * 64, T, wt, nullptr, D, blockIdx.x * 64, D, e); }
__global__ void __launch_bounds__(256) k_rowss(const float* h, float* ss) {
    const int row = blockIdx.x * 4 + (threadIdx.x >> 6), lane = threadIdx.x & 63; const float* p = h + (size_t)row * D; float s = 0.f;
#pragma unroll
    for (int j = 0; j < 16; ++j) { const float v = p[lane + 64 * j]; s += v * v; }
    s = wave_sum(s); if (lane < 16) ss[row * 16 + lane] = lane == 0 ? s : 0.f;
}
__device__ __forceinline__ float row_rstd(const float* ss, int row) { float s = 0.f;
#pragma unroll
    for (int i = 0; i < 16; ++i) s += ss[row * 16 + i];
    return rsqrtf(s * (1.f / D) + EPS); }

__global__ void __launch_bounds__(64) k_router(const float* h1, const float* ss, const float* ln_moe, const float* w_router, const float* e_bias,
                                               unsigned* cnt, int* rowtok, float* topw, unsigned* topd) {
    __shared__ float s_sel[64], s_sc[64], s_gs[8]; __shared__ int s_e[8]; __shared__ float s_w[8];
    const int t = blockIdx.x, e = threadIdx.x;
    const float rstd = row_rstd(ss, t); const float* hp = h1 + (size_t)t * D;
    float acc = 0.f;
    for (int k = 0; k < D; ++k) acc += (hp[k] * rstd * ln_moe[k]) * w_router[k * 64 + e];
    const float sc = 1.f / (1.f + expf(-acc));
    s_sc[e] = sc; s_sel[e] = sc + e_bias[e];
    __syncthreads();
    if (e == 0) {
        unsigned gmask = 0u;
        for (int g = 0; g < 8; ++g) { float m1 = -INFINITY, m2 = -INFINITY; for (int i = 0; i < 8; ++i) { const float v = s_sel[g * 8 + i]; if (v > m1) { m2 = m1; m1 = v; } else if (v > m2) m2 = v; } s_gs[g] = m1 + m2; }
        for (int r = 0; r < 4; ++r) { int best = -1; float bv = -INFINITY; for (int g = 0; g < 8; ++g) if (!((gmask >> g) & 1u) && (best < 0 || s_gs[g] > bv)) { best = g; bv = s_gs[g]; } gmask |= 1u << best; }
        unsigned long long used = 0ull; for (int i = 0; i < 64; ++i) if (!((gmask >> (i >> 3)) & 1u)) used |= 1ull << i;
        float wsum = 0.f;
        for (int r = 0; r < 8; ++r) { int best = -1; float bv = -INFINITY; for (int i = 0; i < 64; ++i) if (!((used >> i) & 1ull) && (best < 0 || s_sel[i] > bv)) { best = i; bv = s_sel[i]; } used |= 1ull << best; s_e[r] = best; s_w[r] = s_sc[best]; wsum += s_sc[best]; }
        for (int r = 0; r < 8; ++r) s_w[r] = s_w[r] / wsum * 2.5f;
    }
    __syncthreads();
    if (e < 8) { const int ex = s_e[e]; const unsigned pos = atomicAdd(&cnt[ex], 1u); rowtok[ex * ECAP + pos] = t; topw[t * 8 + e] = s_w[e]; topd[t * 8 + e] = ((unsigned)ex << 16) | pos; }
}
__global__ void k_offsets(unsigned* ctl) { if (threadIdx.x == 0) { unsigned o = 0; for (int e = 0; e < NE; ++e) { ctl[64 + e] = o; o += ctl[e]; } ctl[64 + NE] = o; } }

struct EpiUp { bf16* act; const float* ss; const int* rowtok; size_t rowbase;
    __device__ void operator()(int r, int c, float g, float u) const { const int tok = rowtok ? rowtok[r] : r; const float rs = row_rstd(ss, tok); const float gg = g * rs, uu = u * rs;
        act[(rowbase + r) * FE + c] = f2bf(gg / (1.f + __expf(-gg)) * uu); } };
struct WrapUp { EpiUp e; int sub; __device__ void operator()(int r, int c, float a, float b) const { e(r, c - sub, a, b); } };
__global__ void __launch_bounds__(256) k_moe_up(const bf16* h1b, const bf16* w13, const unsigned* ctl, const int* rowtok, const float* ss, bf16* act) {
    const int e = blockIdx.z, n = (int)ctl[e], r0 = blockIdx.y * 64; if (r0 >= n) return;
    const int ct = blockIdx.x;
    const int c0 = ct * 64, brow = (c0 >> 7) * 256 + (c0 & 127);
    const bf16* B = w13 + (size_t)e * 512 * 1024;
    EpiUp ep{act, ss, rowtok + e * ECAP, (size_t)ctl[64 + e]};
    WrapUp wr{ep, brow - c0};
    ngemm_tile(h1b, D, rowtok + e * ECAP, r0, n, B, B + (size_t)128 * 1024, D, brow, D, wr);
}
__global__ void __launch_bounds__(256) k_shared_up(const bf16* h1b, const bf16* w13, const float* ss, bf16* act) {
    const int r0 = blockIdx.y * 64, c0 = blockIdx.x * 64, brow = (c0 >> 7) * 256 + (c0 & 127);
    const bf16* B = w13 + (size_t)NE * 512 * 1024;
    EpiUp ep{act, ss, nullptr, (size_t)131072};
    WrapUp wr{ep, brow - c0};
    ngemm_tile(h1b, D, nullptr, r0, T, B, B + (size_t)128 * 1024, D, brow, D, wr);
}
struct EpiDown { unsigned char* yb; size_t rowbase; __device__ void operator()(int r, int c, float a, float) const { yb[(rowbase + r) * D + c] = f2fp8(a * YSCALE); } };
__global__ void __launch_bounds__(256) k_moe_down(const bf16* act, const bf16* w2, const unsigned* ctl, unsigned char* yb) {
    const int e = blockIdx.z, n = (int)ctl[e], r0 = blockIdx.y * 64; if (r0 >= n) return;
    const size_t base = ctl[64 + e];
    EpiDown ep{yb, base};
    ngemm_tile(act + base * FE, FE, nullptr, r0, n, w2 + (size_t)e * D * FE, nullptr, FE, blockIdx.x * 64, FE, ep);
}
struct EpiSharedDown { float* out; __device__ void operator()(int r, int c, float a, float) const { out[(size_t)r * D + c] += a; } };
__global__ void __launch_bounds__(256) k_shared_down(const bf16* act, const bf16* w2, float* out) {
    EpiSharedDown ep{out};
    ngemm_tile(act + (size_t)131072 * FE, FE, nullptr, blockIdx.y * 64, T, w2 + (size_t)NE * D * FE, nullptr, FE, blockIdx.x * 64, FE, ep);
}
__global__ void __launch_bounds__(256) k_combine(float* out, const unsigned char* yb, const float* topw, const unsigned* topd, const unsigned* ctl, bf16* h2b) {
    const int t = blockIdx.x;
    for (int c = threadIdx.x; c < D; c += 256) {
        float h = out[(size_t)t * D + c];
#pragma unroll
        for (int k = 0; k < 8; ++k) { const unsigned d = topd[t * 8 + k]; const size_t row = (size_t)ctl[64 + (d >> 16)] + (d & 0xffffu); h += topw[t * 8 + k] * (fp82f(yb[row * D + c]) * (1.f / YSCALE)); }
        out[(size_t)t * D + c] = h; h2b[(size_t)t * D + c] = f2bf(h);
    }
}
struct EpiGate { bf16* g; const float* ss; __device__ void operator()(int r, int c, float a, float) const { g[(size_t)r * D + c] = f2bf(sigmoidf_(a * row_rstd(ss, r))); } };
__global__ void __launch_bounds__(256) k_gemm_gate(const bf16* h2b, const bf16* wt, EpiGate e) { ngemm_tile(h2b, D, nullptr, blockIdx.y * 64, T, wt, nullptr, D, blockIdx.x * 64, D, e); }
struct EpiProj { float* out; const bf16* g; __device__ void operator()(int r, int c, float a, float) const { const size_t i = (size_t)r * D + c; out[i] += bf2f(g[i]) * a; } };
__global__ void __launch_bounds__(256) k_gemm_proj(const bf16* pb, const bf16* wt, EpiProj e) { ngemm_tile(pb, DPLE, nullptr, blockIdx.y * 64, T, wt, nullptr, DPLE, blockIdx.x * 64, DPLE, e); }
__global__ void __launch_bounds__(256) k_final(float* out, const float* ln_f) {
    const int row = blockIdx.x * 4 + (threadIdx.x >> 6), lane = threadIdx.x & 63; float* p = out + (size_t)row * D; float v[16]; float s = 0.f;
#pragma unroll
    for (int j = 0; j < 16; ++j) { v[j] = p[lane + 64 * j]; s += v[j] * v[j]; }
    const float rstd = rsqrtf(wave_sum(s) * (1.f / D) + EPS);
#pragma unroll
    for (int j = 0; j < 16; ++j) p[lane + 64 * j] = v[j] * rstd * ln_f[lane + 64 * j];
}

extern "C" void kernel_launch(void* const* d_in, const int* in_sizes, int n_in, void* d_out, int out_size, void* d_ws, size_t ws_size, hipStream_t stream) {
    if (n_in != 32 || ws_size < WS_END || out_size != T * D) return;
    const float* x = (const float*)d_in[0]; const float* p = (const float*)d_in[1]; const int* positions = (const int*)d_in[2];
    const float* ln_mix = (const float*)d_in[3]; const float* w_in = (const float*)d_in[4]; const float* conv_w = (const float*)d_in[5]; const float* conv_b = (const float*)d_in[6];
    const float* w_a = (const float*)d_in[7]; const float* b_a = (const float*)d_in[8]; const float* w_i = (const float*)d_in[9]; const float* b_i = (const float*)d_in[10];
    const float* rg_lambda = (const float*)d_in[11]; const float* g_rec = (const float*)d_in[12];
    const float* lq1 = (const float*)d_in[13]; const float* lk1 = (const float*)d_in[14]; const float* lq2 = (const float*)d_in[15]; const float* lk2 = (const float*)d_in[16];
    const float* g_sub = (const float*)d_in[17]; const float* w_out = (const float*)d_in[18]; const float* ln_moe = (const float*)d_in[19]; const float* w_router = (const float*)d_in[20];
    const float* e_bias = (const float*)d_in[21]; const float* w1 = (const float*)d_in[22]; const float* w3 = (const float*)d_in[23]; const float* w2 = (const float*)d_in[24];
    const float* ws1 = (const float*)d_in[25]; const float* ws3 = (const float*)d_in[26]; const float* ws2 = (const float*)d_in[27];
    const float* ln_ple = (const float*)d_in[28]; const float* w_pg = (const float*)d_in[29]; const float* w_pp = (const float*)d_in[30]; const float* ln_f = (const float*)d_in[31];
    float* out = (float*)d_out; unsigned char* ws = (unsigned char*)d_ws;
    unsigned* ctl = (unsigned*)(ws + WS_CTL); float* rope = (float*)(ws + WS_ROPE); float* ss = (float*)(ws + WS_SS);
    float* topw = (float*)(ws + WS_TOPW); unsigned* topd = (unsigned*)(ws + WS_TOPD); int* rowtok = (int*)(ws + WS_ROWTOK);
    bf16* WoutT = (bf16*)(ws + WS_WOUT); bf16* WpgT = (bf16*)(ws + WS_WPG); bf16* WppT = (bf16*)(ws + WS_WPP); bf16* WinT = (bf16*)(ws + WS_WIN);
    bf16* W2T = (bf16*)(ws + WS_W2); bf16* W13T = (bf16*)(ws + WS_W13);
    bf16* XB = (bf16*)(ws + WS_XB); bf16* MIX = (bf16*)(ws + WS_MIX); bf16* ZA = (bf16*)(ws + WS_ZA); bf16* H1B = (bf16*)(ws + WS_H1B);
    bf16* Q = (bf16*)(ws + WS_Q); bf16* K = (bf16*)(ws + WS_K); bf16* V = (bf16*)(ws + WS_V); bf16* O = (bf16*)(ws + WS_O);
    bf16* ACT = (bf16*)(ws + WS_ACT); unsigned char* YB = ws + WS_YB; bf16* H2B = (bf16*)(ws + WS_H2B); bf16* PB = (bf16*)(ws + WS_PB); bf16* G = (bf16*)(ws + WS_G);

    hipMemsetAsync(ctl, 0, 4096, stream);
    k_wconv<<<dim3(DIN / 32, D / 32, 1), 256, 0, stream>>>(w_in, D, DIN, ln_mix, WinT, 0, 0, 0, 0);
    k_wconv<<<dim3(D / 32, D / 32, 1), 256, 0, stream>>>(w_out, D, D, nullptr, WoutT, 0, 0, 0, 0);
    k_wconv<<<dim3(D / 32, D / 32, 1), 256, 0, stream>>>(w_pg, D, D, ln_ple, WpgT, 0, 0, 0, 0);
    k_wconv<<<dim3(D / 32, DPLE / 32, 1), 256, 0, stream>>>(w_pp, DPLE, D, nullptr, WppT, 0, 0, 0, 0);
    k_wconv<<<dim3(FE / 32, D / 32, NE), 256, 0, stream>>>(w1, D, FE, ln_moe, W13T, 1, 0, (size_t)D * FE, (size_t)512 * D);
    k_wconv<<<dim3(FE / 32, D / 32, NE), 256, 0, stream>>>(w3, D, FE, ln_moe, W13T, 1, 1, (size_t)D * FE, (size_t)512 * D);
    k_wconv<<<dim3(FE / 32, D / 32, 1), 256, 0, stream>>>(ws1, D, FE, ln_moe, W13T + (size_t)NE * 512 * D, 1, 0, 0, 0);
    k_wconv<<<dim3(FE / 32, D / 32, 1), 256, 0, stream>>>(ws3, D, FE, ln_moe, W13T + (size_t)NE * 512 * D, 1, 1, 0, 0);
    k_wconv<<<dim3(D / 32, FE / 32, NE), 256, 0, stream>>>(w2, FE, D, nullptr, W2T, 0, 0, (size_t)FE * D, (size_t)D * FE);
    k_wconv<<<dim3(D / 32, FE / 32, 1), 256, 0, stream>>>(ws2, FE, D, nullptr, W2T + (size_t)NE * D * FE, 0, 0, 0, 0);
    k_xnorm<<<T / 4, 256, 0, stream>>>(x, XB);
    k_rope_table<<<T * 8 / 256, 256, 0, stream>>>(positions, rope);
    k_gemm1<<<dim3(DIN / 64, T / 64), 256, 0, stream>>>(XB, WinT, Epi1{ZA, Q, K, V});
    k_rope<<<T * 256 / 256, 256, 0, stream>>>(Q, K, rope);
    k_rglru<<<NBATCH * 8, 64, 0, stream>>>(ZA, conv_w, conv_b, w_a, b_a, w_i, b_i, rg_lambda, MIX);
    k_recnorm<<<T / 4, 256, 0, stream>>>(MIX, g_rec);
    k_attn<<<T * 16 / 4, 256, 0, stream>>>(Q, K, V, O);
    k_attmix<<<T / 4, 256, 0, stream>>>(O, lq1, lk1, lq2, lk2, g_sub, MIX);
    k_gemm_out<<<dim3(D / 64, T / 64), 256, 0, stream>>>(MIX, WoutT, EpiOut{x, out, H1B});
    k_rowss<<<T / 4, 256, 0, stream>>>(out, ss);
    k_router<<<T, 64, 0, stream>>>(out, ss, ln_moe, w_router, e_bias, ctl, rowtok, topw, topd);
    k_offsets<<<1, 64, 0, stream>>>(ctl);
    k_moe_up<<<dim3(FE / 64, ECAP / 64, NE), 256, 0, stream>>>(H1B, W13T, ctl, rowtok, ss, ACT);
    k_shared_up<<<dim3(FE / 64, T / 64), 256, 0, stream>>>(H1B, W13T, ss, ACT);
    k_moe_down<<<dim3(D / 64, ECAP / 64, NE), 256, 0, stream>>>(ACT, W2T, ctl, YB);
    k_shared_down<<<dim3(D / 64, T / 64), 256, 0, stream>>>(ACT, W2T, out);
    k_combine<<<T, 256, 0, stream>>>(out, YB, topw, topd, ctl, H2B);
    k_rowss<<<T / 4, 256, 0, stream>>>(out, ss);
    k_cvt_bf16<<<T * DPLE / 256, 256, 0, stream>>>(p, PB, T * DPLE);
    k_gemm_gate<<<dim3(D / 64, T / 64), 256, 0, stream>>>(H2B, WpgT, EpiGate{G, ss});
    k_gemm_proj<<<dim3(D / 64, T / 64), 256, 0, stream>>>(PB, WppT, EpiProj{out, G});
    k_final<<<T / 4, 256, 0, stream>>>(out, ln_f);
}
```

```cpp
#include <hip/hip_runtime.h>
#include <hip/hip_bf16.h>
#include <stdint.h>
#include <math.h>

#ifndef PROBE_PHASE
#define PROBE_PHASE -1
#endif
typedef unsigned short bf16;
typedef unsigned u32x4 __attribute__((ext_vector_type(4)));
#define LAS __attribute__((address_space(3)))

constexpr int T = 16384, SEQ = 4096, NBATCH = 4, D = 1024, DIN = 2560, NE = 64, FE = 256, DPLE = 256;
constexpr int ECAP = 16384;
constexpr int NWAVES = 8, NTHR = 512;
constexpr int CHUNK = 64, NCHUNK = SEQ / CHUNK;
constexpr float EPS = 1e-6f;
constexpr float LAM_INIT = 0.2f;
constexpr float YSCALE = 16.f;
constexpr float W2SCALE = 16.f, ASCALE = 8.f;
constexpr float H2SCALE = 8.f, WPGSCALE = 32.f;
constexpr float H1SCALE = 8.f;
constexpr float W13SCALE = 32.f;
constexpr float C2 = 0.125f * 1.4426950408889634f;

constexpr size_t MiB = 1u << 20;
constexpr size_t WS_CTL = 0, CTL_ZERO_BYTES = 128 * 1024;
constexpr int CW_BAR = 4096;
constexpr size_t WS_RSTD1 = 256 * 1024;
constexpr size_t WS_RSTD2 = 320 * 1024;
constexpr size_t WS_WG = 448 * 1024;
constexpr size_t WS_IDENT = 384 * 1024;
constexpr size_t WS_RX = 576 * 1024;
constexpr size_t WS_XS = 640 * 1024;
constexpr size_t WS_ROPE = 1 * MiB;
constexpr size_t WS_SUM = 2 * MiB;
constexpr size_t WS_TOPW = 3 * MiB;
constexpr size_t WS_TOPD = 3 * MiB + 512 * 1024;
constexpr size_t WS_ROWTOK = 4 * MiB;
constexpr size_t WS_WOUT = 8 * MiB;
constexpr size_t WS_WPG = 15 * MiB;
constexpr size_t WS_WPP = 17 * MiB;
constexpr size_t WS_WR = 17 * MiB + 512 * 1024;
constexpr size_t WS_WIN = 10 * MiB;
constexpr size_t WS_W2 = 18 * MiB;
constexpr size_t WS_W13 = 51 * MiB;
constexpr size_t WS_XB = 116 * MiB;
constexpr size_t WS_MIX = 180 * MiB;
constexpr size_t WS_ZA = 148 * MiB;
constexpr size_t WS_H1B = 260 * MiB;
constexpr size_t WS_Q = 180 * MiB, WS_K = 196 * MiB, WS_V = 212 * MiB;
constexpr size_t WS_O = 228 * MiB;
constexpr size_t WS_ACT = 196 * MiB;
constexpr size_t WS_YB = 51 * MiB;
constexpr size_t WS_H2B = 228 * MiB;
constexpr size_t WS_PB = 4 * MiB;
constexpr size_t WS_G = 196 * MiB;
constexpr size_t WS_H2F8 = 260 * MiB;
constexpr size_t WS_H3B = 51 * MiB;
constexpr size_t WS_LAU = 260 * MiB;
constexpr size_t WS_END = 292 * MiB;

constexpr int RING_BYTES = 131072, LDSCTL_OFF = RING_BYTES, MISC_OFF = LDSCTL_OFF + 320, LDS_BYTES = 147456;

__device__ __forceinline__ float bf2f(bf16 v) { return __uint_as_float(((unsigned)v) << 16); }
__device__ __forceinline__ bf16 f2bf(float f) { unsigned u = __float_as_uint(f); return (bf16)((u + 0x7fffu + ((u >> 16) & 1u)) >> 16); }
__device__ __forceinline__ unsigned pk2(float lo, float hi) { return (unsigned)f2bf(lo) | ((unsigned)f2bf(hi) << 16); }
__device__ __forceinline__ unsigned char f2fp8(float v) { int r = __builtin_amdgcn_cvt_pk_fp8_f32(v, v, 0, false); return (unsigned char)(r & 0xff); }
__device__ __forceinline__ float fp82f(unsigned char b) { return __builtin_amdgcn_cvt_f32_fp8((int)b, 0); }
__device__ __forceinline__ float wave_sum(float v) {
#pragma unroll
    for (int o = 1; o < 64; o <<= 1) v += __shfl_xor(v, o);
    return v;
}
__device__ __forceinline__ float sigmoidf_(float x) { return __builtin_amdgcn_rcpf(1.f + __expf(-x)); }
__device__ __forceinline__ float gelu_tanh(float x) { const float y = 1.5957691216057308f * (x + 0.044715f * x * x * x); return x * __builtin_amdgcn_rcpf(1.f + __expf(-y)); }
#define LDS_WAIT() asm volatile("s_waitcnt lgkmcnt(0)" ::: "memory")
__device__ __forceinline__ unsigned hw_slot() { return (unsigned)__builtin_amdgcn_s_getreg((5 << 11) | 4) & 0x3fu; }
__device__ __forceinline__ int opaque_tid() {
    const unsigned w = *(volatile LAS unsigned*)(unsigned)(131072u + 4u * hw_slot());
    int l; asm volatile("v_mbcnt_lo_u32_b32 %0, -1, 0\n\tv_mbcnt_hi_u32_b32 %0, -1, %0" : "=v"(l));
    return (int)(((unsigned)__builtin_amdgcn_readfirstlane((int)w) << 6) | (unsigned)l); }

#define XB_TMO      128
#define XB_XCNT(j)  (256  + 64 * (j))
#define XB_XSUB(j)  (1280 + 64 * (j))
#define XB_XGEN(j)  (2304 + 64 * (j))
#define XB_TOP      3328
#define XB_TOPGEN   3392
#define XCD_BAR_WORDS 3456
#define XB_SPIN_CAP (1u << 20)
__device__ __forceinline__ unsigned xb_ld(unsigned* p)              { return __hip_atomic_load(p, __ATOMIC_RELAXED, __HIP_MEMORY_SCOPE_AGENT); }
__device__ __forceinline__ unsigned xb_add(unsigned* p, unsigned v) { return __hip_atomic_fetch_add(p, v, __ATOMIC_RELAXED, __HIP_MEMORY_SCOPE_AGENT); }
__device__ __forceinline__ unsigned xb_xcc_id() { return (unsigned)__builtin_amdgcn_s_getreg((3 << 11) | 20) & 0xFu; }
#define XB_SPIN(cond, bar) do { unsigned _sp = 0; while (cond) { __builtin_amdgcn_s_sleep(1); \
    if ((++_sp & 255u) == 0u) { if (xb_ld(&(bar)[XB_TMO])) break; if (_sp > XB_SPIN_CAP) { atomicAdd(&(bar)[XB_TMO], 1u); break; } } } } while (0)
struct XcdBarrier { unsigned* bar; unsigned x; volatile LAS unsigned* st; };
__device__ __forceinline__ XcdBarrier xcd_barrier_post(unsigned* bar, volatile LAS unsigned* st) {
    XcdBarrier b; b.bar = bar; b.x = xb_xcc_id(); b.st = st;
    if (opaque_tid() == 0) (void)xb_add(&bar[XB_XCNT(b.x)], 1u);
    return b;
}
__device__ __forceinline__ void xcd_barrier_complete(unsigned* bar, unsigned x, unsigned& nloc, unsigned& nx) {
    const unsigned G = gridDim.x * gridDim.y * gridDim.z;
    unsigned sum, cnt, mine, sp = 0u;
    for (;;) {
        sum = 0u; cnt = 0u; mine = 0u;
#pragma unroll
        for (unsigned j = 0; j < 16; ++j) { const unsigned c = xb_ld(&bar[XB_XCNT(j)]); sum += c; cnt += (c > 0u) ? 1u : 0u; mine = (j == x) ? c : mine; }
        if (sum == G) break;
        __builtin_amdgcn_s_sleep(1);
        if ((++sp & 255u) == 0u) { if (xb_ld(&bar[XB_TMO])) break; if (sp > XB_SPIN_CAP) { atomicAdd(&bar[XB_TMO], 1u); break; } }
    }
    nloc = mine > 0u ? mine : 1u; nx = cnt > 0u ? cnt : 1u;
}
__device__ __forceinline__ void xcd_barrier(const XcdBarrier& b) {
    asm volatile("s_waitcnt vmcnt(0)" ::: "memory");
    __syncthreads();
    if (opaque_tid() == 0) {
        unsigned* bar = b.bar;
        __builtin_amdgcn_s_waitcnt(0);
        unsigned nloc = b.st[0], nx = b.st[1];
        if (nloc == 0u) { xcd_barrier_complete(bar, b.x, nloc, nx); b.st[0] = nloc; b.st[1] = nx; }
        const unsigned old = xb_add(&bar[XB_XSUB(b.x)], 1u);
        const unsigned gen = old / nloc;
        if (old + 1u == (gen + 1u) * nloc) {
            __builtin_amdgcn_fence(__ATOMIC_RELEASE, "agent");
            asm volatile("s_waitcnt vmcnt(0)" ::: "memory");
            const unsigned og = xb_add(&bar[XB_TOP], 1u);
            const unsigned tg = og / nx;
            if (og + 1u == (tg + 1u) * nx) xb_add(&bar[XB_TOPGEN], 1u);
            else XB_SPIN(xb_ld(&bar[XB_TOPGEN]) == tg, bar);
            __builtin_amdgcn_fence(__ATOMIC_ACQUIRE, "agent");
            xb_add(&bar[XB_XGEN(b.x)], 1u);
            asm volatile("s_waitcnt vmcnt(0)" ::: "memory");
        } else {
            XB_SPIN(xb_ld(&bar[XB_XGEN(b.x)]) == gen, bar);
            __builtin_amdgcn_fence(__ATOMIC_ACQUIRE, "agent");
            asm volatile("s_waitcnt vmcnt(0)" ::: "memory");
        }
    }
    __syncthreads();
}

constexpr int NE_P1 = 65, ECAP_ = 16384, IDXBUF = 138240;
namespace pg8 {
#define PG8_LAS __attribute__((address_space(3)))
typedef unsigned short bf16_t;
typedef short bf16x8 __attribute__((ext_vector_type(8)));
typedef float f32x4 __attribute__((ext_vector_type(4)));
typedef unsigned u32x4 __attribute__((ext_vector_type(4)));
constexpr int BM = 256, BK = 64, HALF = 128, HTB = HALF * BK * 2  , STAGE_BYTES = 8 * HTB, NXCD = 8, WGM = 8;

__host__ __device__ __forceinline__ int lds_byte(int r, int c) { const int st = (r >> 4) * 2 + (c >> 5), rr = r & 15, cc = c & 31, ob = rr * 64 + cc * 2; return st * 1024 + (ob ^ (((ob >> 9) & 1) << 5)); }
__host__ __device__ __forceinline__ void stage_rc(int b, int& R, int& C) { const int st = b / 1024, sb = b % 1024, swz = sb ^ (((sb >> 9) & 1) << 5); R = (st >> 1) * 16 + swz / 64; C = (st & 1) * 32 + (swz % 64) / 2; }
__host__ __device__ __forceinline__ int perm32(int rho) { const int n = rho >> 4, i = rho & 15; return 8 * (i >> 2) + 4 * n + (i & 3); }

struct Unit { int pm, pn; };
struct Gemm { const bf16_t* A; const bf16_t* Bt; int M, N, K; };

struct StaticOrder {
    int nM, nN, nwg, G, c;
    __host__ __device__ void init(int M, int N, int G_, int c_) { nM = M / BM; nN = N / BM; nwg = nM * nN; G = G_; c = c_; }
    __host__ __device__ bool next(int i, Unit& u) const {
        const long L = (long)i * G + c; if (L >= nwg) return false;
        int wgid = (int)L; { const int q = nwg / NXCD, r = nwg % NXCD, xcd = wgid % NXCD, off = wgid / NXCD; wgid = (xcd < r ? xcd * (q + 1) : r * (q + 1) + (xcd - r) * q) + off; }
        const int nig = WGM * nN, gid = wgid / nig, fm = gid * WGM, gsz = (nM - fm) < WGM ? (nM - fm) : WGM;
        u.pm = fm + ((wgid % nig) % gsz); u.pn = (wgid % nig) / gsz; return true;
    }
    __device__ __forceinline__ void a_ready(const Unit&) const {}
    __device__ __forceinline__ void done(const Unit&) const {}
};

__device__ __forceinline__ unsigned cvt_pk_bf16(float lo, float hi) { unsigned r; asm volatile("v_cvt_pk_bf16_f32 %0, %1, %2" : "=v"(r) : "v"(lo), "v"(hi)); return r; }
typedef int v8i32 __attribute__((ext_vector_type(8))); typedef int v4i32 __attribute__((ext_vector_type(4)));
__device__ __forceinline__ v8i32 cat8(bf16x8 lo, bf16x8 hi) { const v4i32 a = __builtin_bit_cast(v4i32, lo), b = __builtin_bit_cast(v4i32, hi); return __builtin_shufflevector(a, b, 0, 1, 2, 3, 4, 5, 6, 7); }
template <class Epi, class Sched, bool ALIGN_EPI = false, bool SP2 = false, bool FP8 = false>
__device__ __forceinline__ void gemm_phase(PG8_LAS unsigned char* lds, const Gemm g, const Sched& S, const Epi& E) {
    const int tid = opaque_tid(), wid = __builtin_amdgcn_readfirstlane(tid >> 6), lane = tid & 63, wr = wid >> 2, wc = wid & 3, fr = lane & 15, fq = lane >> 4;
    const int K = g.K, nt = K / BK;
    unsigned voffA[2], voffB[2];
#pragma unroll
    for (int i = 0; i < 2; ++i) { int R, C; stage_rc(tid * 16 + i * 8192, R, C); const int Rb = Epi::PERM ? ((R & ~31) + perm32(R & 31)) : R;
        voffA[i] = (unsigned)(R * K + C) * 2u; voffB[i] = (unsigned)(Rb * K + C) * 2u; }
    const size_t kstep = (size_t)(BK * 2);
    const size_t hstep = (size_t)HALF * K * 2;
    const size_t tstep = 2 * hstep;
    const unsigned ldsw = (unsigned)wid * 1024u;
    const int aoff_ = lds_byte(wr * 64 + fr, fq * 8), boff_ = lds_byte(wc * 32 + fr, fq * 8);
#define aoff (FP8 ? ({ int l_ = aoff_; asm volatile("" : "+v"(l_)); l_; }) : aoff_)
#define boff (FP8 ? ({ int l_ = boff_; asm volatile("" : "+v"(l_)); l_; }) : boff_)
#define PG8_SA(b, h) (((b) * 2 + (h)) * HTB)
#define PG8_SB(b, h) ((4 + (b) * 2 + (h)) * HTB)
#define PG8_STAGE(bufoff, gbase, voff) do { _Pragma("unroll") for (int _i = 0; _i < 2; ++_i) \
        __builtin_amdgcn_global_load_lds((const unsigned*)((const char*)(gbase) + (voff)[_i]), (PG8_LAS unsigned*)(lds + (bufoff) + ldsw + _i * 8192), 16, 0, 0); } while (0)
#define PG8_LDA(dst, b, h) do { _Pragma("unroll") for (int m = 0; m < 4; ++m) _Pragma("unroll") for (int k = 0; k < 2; ++k) dst[m][k] = *(const PG8_LAS bf16x8*)(lds + PG8_SA(b, h) + aoff + m * 2048 + k * 1024); } while (0)
#define PG8_LDB(dst, b, h) do { _Pragma("unroll") for (int n = 0; n < 2; ++n) _Pragma("unroll") for (int k = 0; k < 2; ++k) dst[n][k] = *(const PG8_LAS bf16x8*)(lds + PG8_SB(b, h) + boff + n * 2048 + k * 1024); } while (0)
#define PG8_MMA(ai, bj, At, Bt) do { __builtin_amdgcn_s_setprio(1); if constexpr (FP8) { _Pragma("unroll") for (int m = 0; m < 4; ++m) _Pragma("unroll") for (int n = 0; n < 2; ++n) \
        acc[ai][bj][m][n] = __builtin_amdgcn_mfma_scale_f32_16x16x128_f8f6f4(cat8(Bt[n][0], Bt[n][1]), cat8(At[m][0], At[m][1]), acc[ai][bj][m][n], 0, 0, 0, 0x7f7f7f7f, 0, 0x7f7f7f7f); } \
        else { _Pragma("unroll") for (int m = 0; m < 4; ++m) _Pragma("unroll") for (int n = 0; n < 2; ++n) _Pragma("unroll") for (int k = 0; k < 2; ++k) \
        acc[ai][bj][m][n] = __builtin_amdgcn_mfma_f32_16x16x32_bf16(Bt[n][k], At[m][k], acc[ai][bj][m][n], 0, 0, 0); } __builtin_amdgcn_s_setprio(0); } while (0)
#define PG8_WAIT_V(n) asm volatile("s_waitcnt vmcnt(" #n ")" ::: "memory")
#define PG8_WAIT_L(n) asm volatile("s_waitcnt lgkmcnt(" #n ")" ::: "memory")
#define PG8_BAR __builtin_amdgcn_s_barrier()
#define PG8_SCHED __builtin_amdgcn_sched_barrier(0)
    Unit cur, nxt; int ui = 0;
    if (!S.next(0, cur)) return;
    f32x4 acc[2][2][4][2];
#pragma unroll
    for (int a = 0; a < 2; ++a)
#pragma unroll
        for (int b = 0; b < 2; ++b)
#pragma unroll
            for (int m = 0; m < 4; ++m)
#pragma unroll
                for (int n = 0; n < 2; ++n) acc[a][b][m][n] = (f32x4){0.f, 0.f, 0.f, 0.f};
    bf16x8 At[4][2], B0[2][2], B1[2][2];
    const char* cA = (const char*)g.A + (size_t)cur.pm * tstep; const char* cB = (const char*)g.Bt + (size_t)cur.pn * tstep;
    S.a_ready(cur);
    if constexpr (SP2) {
        PG8_STAGE(PG8_SB(0, 0), cB, voffB); PG8_STAGE(PG8_SB(0, 1), cB + hstep, voffB); PG8_STAGE(PG8_SA(0, 0), cA, voffA); PG8_STAGE(PG8_SA(0, 1), cA + hstep, voffA);
        if (wr == 1) PG8_BAR;
        PG8_WAIT_V(2); PG8_BAR;
        PG8_STAGE(PG8_SB(1, 0), cB + kstep, voffB); PG8_STAGE(PG8_SA(1, 0), cA + kstep, voffA); PG8_STAGE(PG8_SB(1, 1), cB + hstep + kstep, voffB);
        PG8_WAIT_V(6); PG8_BAR;
    } else {
        PG8_STAGE(PG8_SB(0, 0), cB, voffB); PG8_STAGE(PG8_SA(0, 0), cA, voffA); PG8_STAGE(PG8_SB(0, 1), cB + hstep, voffB); PG8_STAGE(PG8_SA(0, 1), cA + hstep, voffA);
        if (wr == 1) PG8_BAR;
        PG8_WAIT_V(4); PG8_BAR;
        PG8_STAGE(PG8_SB(1, 0), cB + kstep, voffB); PG8_STAGE(PG8_SA(1, 0), cA + kstep, voffA); PG8_STAGE(PG8_SB(1, 1), cB + hstep + kstep, voffB);
        PG8_WAIT_V(6); PG8_BAR;
    }
    for (;;) {
        const bool has_next = S.next(ui + 1, nxt);
        const char* nA = has_next ? (const char*)g.A + (size_t)nxt.pm * tstep : cA; const char* nB = has_next ? (const char*)g.Bt + (size_t)nxt.pn * tstep : cB;
        for (int t = 0; t < nt; t += 2) {
            const bool last = (t == nt - 2);
            const char* a1 = cA + (size_t)(t + 1) * kstep;
            const char* a2 = last ? nA : cA + (size_t)(t + 2) * kstep; const char* b2 = last ? nB : cB + (size_t)(t + 2) * kstep;
            const char* a3 = a2 + kstep; const char* b3 = b2 + kstep;
            if (last && has_next) S.a_ready(nxt);
            if constexpr (SP2) {
            PG8_LDB(B0, 0, 0); PG8_LDB(B1, 0, 1); PG8_SCHED; PG8_LDA(At, 0, 0); PG8_STAGE(PG8_SA(1, 1), a1 + hstep, voffA);
            PG8_WAIT_V(8); PG8_WAIT_L(0); PG8_BAR; PG8_MMA(0, 0, At, B0); PG8_MMA(0, 1, At, B1); PG8_BAR; PG8_SCHED;
            PG8_LDA(At, 0, 1); PG8_STAGE(PG8_SB(0, 0), b2, voffB); PG8_STAGE(PG8_SB(0, 1), b2 + hstep, voffB); PG8_STAGE(PG8_SA(0, 0), a2, voffA);
            PG8_WAIT_V(8); PG8_WAIT_L(0); PG8_BAR; PG8_MMA(1, 0, At, B0); PG8_MMA(1, 1, At, B1); PG8_BAR; PG8_SCHED;
            PG8_LDB(B0, 1, 0); PG8_LDB(B1, 1, 1); PG8_SCHED; PG8_LDA(At, 1, 0); PG8_STAGE(PG8_SA(0, 1), a2 + hstep, voffA);
            PG8_WAIT_V(8); PG8_WAIT_L(0); PG8_BAR; PG8_MMA(0, 0, At, B0); PG8_MMA(0, 1, At, B1); PG8_BAR; PG8_SCHED;
            PG8_LDA(At, 1, 1); PG8_STAGE(PG8_SB(1, 0), b3, voffB); PG8_STAGE(PG8_SB(1, 1), b3 + hstep, voffB); PG8_STAGE(PG8_SA(1, 0), a3, voffA);
            PG8_WAIT_V(8); PG8_WAIT_L(0); PG8_BAR; PG8_MMA(1, 0, At, B0); PG8_MMA(1, 1, At, B1); PG8_BAR; PG8_SCHED;
            } else {
            PG8_LDB(B0, 0, 0); PG8_SCHED; PG8_LDA(At, 0, 0); PG8_STAGE(PG8_SA(1, 1), a1 + hstep, voffA);
            PG8_WAIT_L(8); PG8_BAR; PG8_WAIT_L(0); PG8_MMA(0, 0, At, B0); PG8_BAR; PG8_SCHED;
            PG8_LDB(B1, 0, 1); PG8_STAGE(PG8_SB(0, 0), b2, voffB);
            PG8_BAR; PG8_WAIT_L(0); PG8_MMA(0, 1, At, B1); PG8_BAR;
            PG8_LDA(At, 0, 1); PG8_STAGE(PG8_SA(0, 0), a2, voffA);
            PG8_BAR; PG8_WAIT_L(0); PG8_MMA(1, 0, At, B0); PG8_BAR; PG8_SCHED;
            PG8_STAGE(PG8_SB(0, 1), b2 + hstep, voffB);
            PG8_WAIT_V(6); PG8_BAR; PG8_MMA(1, 1, At, B1); PG8_BAR;
            PG8_LDB(B0, 1, 0); PG8_SCHED; PG8_LDA(At, 1, 0); PG8_STAGE(PG8_SA(0, 1), a2 + hstep, voffA);
            PG8_WAIT_L(8); PG8_BAR; PG8_WAIT_L(0); PG8_MMA(0, 0, At, B0); PG8_BAR; PG8_SCHED;
            PG8_LDB(B1, 1, 1); PG8_STAGE(PG8_SB(1, 0), b3, voffB);
            PG8_BAR; PG8_WAIT_L(0); PG8_MMA(0, 1, At, B1); PG8_BAR;
            PG8_LDA(At, 1, 1); PG8_STAGE(PG8_SA(1, 0), a3, voffA);
            PG8_BAR; PG8_WAIT_L(0); PG8_MMA(1, 0, At, B0); PG8_BAR; PG8_SCHED;
            PG8_STAGE(PG8_SB(1, 1), b3 + hstep, voffB);
            PG8_WAIT_V(6); PG8_BAR; PG8_MMA(1, 1, At, B1); PG8_BAR;
            }
        }
        if constexpr (ALIGN_EPI) { if (wr == 0) PG8_BAR; }
        if constexpr (!Epi::AFTER_DRAIN) { const int lo_ = opaque_tid() & 63; E(acc, cur, wr, wc, lo_ & 15, lo_ >> 4); S.done(cur); }
        if (!has_next) break;
#pragma unroll
        for (int a = 0; a < 2; ++a)
#pragma unroll
            for (int b = 0; b < 2; ++b)
#pragma unroll
                for (int m = 0; m < 4; ++m)
#pragma unroll
                    for (int n = 0; n < 2; ++n) acc[a][b][m][n] = (f32x4){0.f, 0.f, 0.f, 0.f};
        cur = nxt; cA = nA; cB = nB; ++ui;
        if constexpr (ALIGN_EPI) { if (wr == 1) PG8_BAR; }
    }
    PG8_WAIT_V(0);
    if constexpr (!ALIGN_EPI) { if (wr == 0) PG8_BAR; }
    PG8_BAR;
    if constexpr (Epi::AFTER_DRAIN) { const int lo_ = opaque_tid() & 63; E.fused(acc, cur, wr, wc, lo_ & 15, lo_ >> 4, lds, wid, lo_); S.done(cur); }
#undef aoff
#undef boff
#undef PG8_SA
#undef PG8_SB
#undef PG8_STAGE
#undef PG8_LDA
#undef PG8_LDB
#undef PG8_MMA
#undef PG8_WAIT_V
#undef PG8_WAIT_L
#undef PG8_BAR
#undef PG8_SCHED
}
}

namespace pg8 {
__device__ __forceinline__ u32x4 pack8(const f32x4& a, const f32x4& b) { u32x4 w; w.x = cvt_pk_bf16(a[0], a[1]); w.y = cvt_pk_bf16(a[2], a[3]); w.z = cvt_pk_bf16(b[0], b[1]); w.w = cvt_pk_bf16(b[2], b[3]); return w; }
struct EpiG1 {
    static constexpr bool PERM = true, AFTER_DRAIN = false;
    bf16_t *za, *q, *k, *v; const float* cs;
    __device__ __forceinline__ void operator()(const f32x4 (&acc)[2][2][4][2], const Unit& u, int wr, int wc, int fr, int fq) const {
        const int row0 = u.pm * BM + wr * 64 + fr, pn = u.pn, cw = wc * 32 + 8 * fq;
        if (pn < 4 || pn >= 8) {
            bf16_t* base = pn < 4 ? za : v; const int ld = pn < 4 ? 1024 : 512, ct = pn < 4 ? pn * 256 : (pn - 8) * 256;
#pragma unroll
            for (int ai = 0; ai < 2; ++ai)
#pragma unroll
                for (int m = 0; m < 4; ++m) { bf16_t* rowp = base + (size_t)(row0 + ai * HALF + m * 16) * ld + ct + cw;
#pragma unroll
                    for (int bj = 0; bj < 2; ++bj) *(u32x4*)(rowp + bj * HALF) = pack8(acc[ai][bj][m][0], acc[ai][bj][m][1]); }
        } else {
            const bool isq = pn < 6; bf16_t* base = isq ? q : k; const int ct = (pn - (isq ? 4 : 6)) * 256; const float sc = isq ? 0.18033688011112042f : 1.f;
            const bool ropew = (wc & 1) == 0;
            const float sgn = fq == 0 ? -1.f : 1.f;
#pragma unroll
            for (int ai = 0; ai < 2; ++ai)
#pragma unroll
                for (int m = 0; m < 4; ++m) { const int row = row0 + ai * HALF + m * 16; bf16_t* rowp = base + (size_t)row * 512 + ct + cw;
                    f32x4 c0 = {1.f, 1.f, 1.f, 1.f}, c1 = c0, s0 = {0.f, 0.f, 0.f, 0.f}, s1 = s0;
                    if (ropew && fq < 2) { const f32x4* cp = (const f32x4*)(cs + (size_t)row * 16); c0 = cp[0]; c1 = cp[1]; s0 = cp[2] * sgn; s1 = cp[3] * sgn; }
#pragma unroll
                    for (int bj = 0; bj < 2; ++bj) { f32x4 a = acc[ai][bj][m][0], b = acc[ai][bj][m][1];
                        if (ropew) { f32x4 pa, pb;
#pragma unroll
                            for (int i = 0; i < 4; ++i) { pa[i] = __shfl_xor(a[i], 16); pb[i] = __shfl_xor(b[i], 16); }
                            a = a * c0 + pa * s0; b = b * c1 + pb * s1; }
                        a = a * sc; b = b * sc;
                        *(u32x4*)(rowp + bj * HALF) = pack8(a, b); } }
        }
    }
};
__device__ __forceinline__ void unpack8(const u32x4 w, f32x4& a, f32x4& b) { a[0] = __uint_as_float(w.x << 16); a[1] = __uint_as_float(w.x & 0xffff0000u); a[2] = __uint_as_float(w.y << 16); a[3] = __uint_as_float(w.y & 0xffff0000u);
    b[0] = __uint_as_float(w.z << 16); b[1] = __uint_as_float(w.z & 0xffff0000u); b[2] = __uint_as_float(w.w << 16); b[3] = __uint_as_float(w.w & 0xffff0000u); }
struct EpiOutF {
    static constexpr bool PERM = true, AFTER_DRAIN = false;
    const bf16_t* xb; const float* rx; bf16_t* hb;
    __device__ __forceinline__ void operator()(const f32x4 (&acc)[2][2][4][2], const Unit& u, int wr, int wc, int fr, int fq) const {
        const int row0 = u.pm * BM + wr * 64 + fr, col0 = u.pn * BM + wc * 32 + 8 * fq;
#pragma unroll
        for (int ai = 0; ai < 2; ++ai)
#pragma unroll
            for (int m = 0; m < 4; ++m) { const int row = row0 + ai * HALF + m * 16; const float r = rx[row]; const size_t off = (size_t)row * 1024 + col0;
#pragma unroll
                for (int bj = 0; bj < 2; ++bj) { f32x4 x0, x1; unpack8(*(const u32x4*)(xb + off + bj * HALF), x0, x1);
                    const f32x4 h0 = x0 * r + acc[ai][bj][m][0], h1 = x1 * r + acc[ai][bj][m][1];
                    *(u32x4*)(hb + off + bj * HALF) = pack8(h0, h1); } }
    }
};
__device__ __forceinline__ f32x4 sig4(f32x4 v) { f32x4 r;
#pragma unroll
    for (int i = 0; i < 4; ++i) r[i] = __builtin_amdgcn_rcpf(1.f + __expf(-v[i]));
    return r; }
struct EpiGateFused {
    static constexpr bool PERM = true, AFTER_DRAIN = false;
    bf16_t* h3b; const bf16_t* h2b; const bf16_t* pp; float cs;
    __device__ __forceinline__ void operator()(const f32x4 (&acc)[2][2][4][2], const Unit& u, int wr, int wc, int fr, int fq) const {
        const int row0 = u.pm * BM + wr * 64 + fr, col0 = u.pn * BM + wc * 32 + 8 * fq;
#pragma unroll
        for (int ai = 0; ai < 2; ++ai)
#pragma unroll
            for (int m = 0; m < 4; ++m) { const int row = row0 + ai * HALF + m * 16; const float rs = cs; const size_t off = (size_t)row * 1024 + col0;
#pragma unroll
                for (int bj = 0; bj < 2; ++bj) { f32x4 g0, g1, q0, q1; unpack8(*(const u32x4*)(pp + off + bj * HALF), g0, g1); unpack8(*(const u32x4*)(h2b + off + bj * HALF), q0, q1);
                    *(u32x4*)(h3b + off + bj * HALF) = pack8(q0 + sig4(acc[ai][bj][m][0] * rs) * g0, q1 + sig4(acc[ai][bj][m][1] * rs) * g1); } }
    }
};
struct EpiStoreBf16 {
    static constexpr bool PERM = true, AFTER_DRAIN = false;
    bf16_t* o;
    __device__ __forceinline__ void operator()(const f32x4 (&acc)[2][2][4][2], const Unit& u, int wr, int wc, int fr, int fq) const {
        const int row0 = u.pm * BM + wr * 64 + fr, col0 = u.pn * BM + wc * 32 + 8 * fq;
#pragma unroll
        for (int ai = 0; ai < 2; ++ai)
#pragma unroll
            for (int m = 0; m < 4; ++m) { const size_t off = (size_t)(row0 + ai * HALF + m * 16) * 1024 + col0;
#pragma unroll
                for (int bj = 0; bj < 2; ++bj) *(u32x4*)(o + off + bj * HALF) = pack8(acc[ai][bj][m][0], acc[ai][bj][m][1]); }
    }
};
}


namespace pg8 {
struct GUnit { int e, rb, pn; };
template <class Epi, class Sched, bool ALIGN_EPI, bool GATHER, bool FP8 = false>
__device__ __forceinline__ void gemm_phase_g(PG8_LAS unsigned char* lds, const bf16_t* A, const int K, const Sched& S, const Epi& E) {
    const int tid = opaque_tid(), wid = __builtin_amdgcn_readfirstlane(tid >> 6), lane = tid & 63, wr = wid >> 2, wc = wid & 3, fr = lane & 15, fq = lane >> 4;
    const int nt = K / BK;
    unsigned voffB0[2]; int RA[2]; unsigned CA2[2];
#pragma unroll
    for (int i = 0; i < 2; ++i) { int R, C; stage_rc(tid * 16 + i * 8192, R, C); const int Rb = Epi::PERM ? ((R & ~31) + perm32(R & 31)) : R;
        voffB0[i] = (unsigned)(Rb * K + C) * 2u; RA[i] = R; CA2[i] = (unsigned)C * 2u; }
    const size_t kstep = (size_t)(BK * 2);
    const size_t hstep = (size_t)HALF * K * 2;
    const unsigned ldsw = (unsigned)wid * 1024u;
    const int aoff_ = lds_byte(wr * 64 + fr, fq * 8), boff_ = lds_byte(wc * 32 + fr, fq * 8);
#define aoff (FP8 ? ({ int l_ = aoff_; asm volatile("" : "+v"(l_)); l_; }) : aoff_)
#define boff (FP8 ? ({ int l_ = boff_; asm volatile("" : "+v"(l_)); l_; }) : boff_)
#define PG8_SA(b, h) (((b) * 2 + (h)) * HTB)
#define PG8_SB(b, h) ((4 + (b) * 2 + (h)) * HTB)
#define PG8_STAGE(bufoff, gbase, voff) do { _Pragma("unroll") for (int _i = 0; _i < 2; ++_i) \
        __builtin_amdgcn_global_load_lds((const unsigned*)((const char*)(gbase) + (voff)[_i]), (PG8_LAS unsigned*)(lds + (bufoff) + ldsw + _i * 8192), 16, 0, 0); } while (0)
#define PG8_STAGE_A1(bufoff, gbase) do { if constexpr (GATHER) { PG8_STAGE(bufoff, gbase, vc1); } else { const unsigned v1_[2] = {vc0[0] + (unsigned)hstep, vc0[1] + (unsigned)hstep}; PG8_STAGE(bufoff, gbase, v1_); } } while (0)
#define PG8_LDA(dst, b, h) do { _Pragma("unroll") for (int m = 0; m < 4; ++m) _Pragma("unroll") for (int k = 0; k < 2; ++k) dst[m][k] = *(const PG8_LAS bf16x8*)(lds + PG8_SA(b, h) + aoff + m * 2048 + k * 1024); } while (0)
#define PG8_LDB(dst, b, h) do { _Pragma("unroll") for (int n = 0; n < 2; ++n) _Pragma("unroll") for (int k = 0; k < 2; ++k) dst[n][k] = *(const PG8_LAS bf16x8*)(lds + PG8_SB(b, h) + boff + n * 2048 + k * 1024); } while (0)
#define PG8_MMA(ai, bj, At, Bt) do { __builtin_amdgcn_s_setprio(1); if constexpr (FP8) { _Pragma("unroll") for (int m = 0; m < 4; ++m) _Pragma("unroll") for (int n = 0; n < 2; ++n) \
        acc[ai][bj][m][n] = __builtin_amdgcn_mfma_scale_f32_16x16x128_f8f6f4(cat8(Bt[n][0], Bt[n][1]), cat8(At[m][0], At[m][1]), acc[ai][bj][m][n], 0, 0, 0, 0x7f7f7f7f, 0, 0x7f7f7f7f); } \
        else { _Pragma("unroll") for (int m = 0; m < 4; ++m) _Pragma("unroll") for (int n = 0; n < 2; ++n) _Pragma("unroll") for (int k = 0; k < 2; ++k) \
        acc[ai][bj][m][n] = __builtin_amdgcn_mfma_f32_16x16x32_bf16(Bt[n][k], At[m][k], acc[ai][bj][m][n], 0, 0, 0); } __builtin_amdgcn_s_setprio(0); } while (0)
#define PG8_WAIT_V(n) asm volatile("s_waitcnt vmcnt(" #n ")" ::: "memory")
#define PG8_WAIT_L(n) asm volatile("s_waitcnt lgkmcnt(" #n ")" ::: "memory")
#define PG8_BAR __builtin_amdgcn_s_barrier()
#define PG8_SCHED __builtin_amdgcn_sched_barrier(0)
    GUnit cur, nxt; int ui = 0;
    if (!S.next(0, cur)) return;
    f32x4 acc[2][2][4][2];
#pragma unroll
    for (int a = 0; a < 2; ++a)
#pragma unroll
        for (int b = 0; b < 2; ++b)
#pragma unroll
            for (int m = 0; m < 4; ++m)
#pragma unroll
                for (int n = 0; n < 2; ++n) acc[a][b][m][n] = (f32x4){0.f, 0.f, 0.f, 0.f};
    bf16x8 At[4][2], B0[2][2], B1[2][2];
    unsigned vc0[2], vc1[2];
#pragma unroll
    for (int i = 0; i < 2; ++i) { vc0[i] = S.arow_off(cur, RA[i]) + CA2[i]; vc1[i] = S.arow_off(cur, RA[i] + HALF) + CA2[i]; }
    const char* const kA = (const char*)A; const char* cB = S.bbase(cur);
    PG8_STAGE(PG8_SB(0, 0), cB, voffB0); PG8_STAGE(PG8_SB(0, 1), cB + hstep, voffB0); PG8_STAGE(PG8_SA(0, 0), kA, vc0); PG8_STAGE_A1(PG8_SA(0, 1), kA);
    if (wr == 1) PG8_BAR;
    PG8_WAIT_V(2); PG8_BAR;
    PG8_STAGE(PG8_SB(1, 0), cB + kstep, voffB0); PG8_STAGE(PG8_SA(1, 0), kA + kstep, vc0); PG8_STAGE(PG8_SB(1, 1), cB + hstep + kstep, voffB0);
    PG8_WAIT_V(6); PG8_BAR;
    for (;;) {
        const bool has_next = S.next(ui + 1, nxt);
        const char* nB = has_next ? S.bbase(nxt) : cB;
        if (GATHER && has_next) {
            int tg = tid; asm volatile("" : "+v"(tg));
#pragma unroll
            for (int i = 0; i < 2; ++i) { int R, C; stage_rc(tg * 16 + i * 8192, R, C);
                __builtin_amdgcn_global_load_lds((const unsigned*)S.row_ptr(nxt, R), (PG8_LAS unsigned*)(lds + IDXBUF + ((2 * i) * 8 + wid) * 256), 4, 0, 0);
                __builtin_amdgcn_global_load_lds((const unsigned*)S.row_ptr(nxt, R + HALF), (PG8_LAS unsigned*)(lds + IDXBUF + ((2 * i + 1) * 8 + wid) * 256), 4, 0, 0); }
        }
        for (int t = 0; t < nt; t += 2) {
            const bool last = (t == nt - 2);
            unsigned voffB[2];
            { int tb = tid; asm volatile("" : "+v"(tb));
#pragma unroll
              for (int i = 0; i < 2; ++i) { int R, C; stage_rc(tb * 16 + i * 8192, R, C); const int Rb = Epi::PERM ? ((R & ~31) + perm32(R & 31)) : R; voffB[i] = (unsigned)(Rb * K + C) * 2u; } }
            const char* a1 = kA + (size_t)(t + 1) * kstep;
            const char* a2 = last ? kA : kA + (size_t)(t + 2) * kstep; const char* b2 = last ? nB : cB + (size_t)(t + 2) * kstep;
            const char* a3 = a2 + kstep; const char* b3 = b2 + kstep;
            PG8_STAGE_A1(PG8_SA(1, 1), a1);
            if (last && has_next) {
                int tt = tid; asm volatile("" : "+v"(tt));
#pragma unroll
                for (int i = 0; i < 2; ++i) { int R, C; stage_rc(tt * 16 + i * 8192, R, C); const unsigned c2 = (unsigned)C * 2u;
                    if (GATHER) { const unsigned i0 = *(const PG8_LAS unsigned*)(lds + IDXBUF + ((2 * i) * 8 + wid) * 256 + lane * 4), i1 = *(const PG8_LAS unsigned*)(lds + IDXBUF + ((2 * i + 1) * 8 + wid) * 256 + lane * 4);
                        vc0[i] = i0 * (unsigned)(K * 2) + c2; vc1[i] = i1 * (unsigned)(K * 2) + c2; }
                    else { vc0[i] = S.arow_off(nxt, R) + c2; vc1[i] = S.arow_off(nxt, R + HALF) + c2; } }
            }
            PG8_LDB(B0, 0, 0); PG8_LDB(B1, 0, 1); PG8_SCHED; PG8_LDA(At, 0, 0);
            PG8_WAIT_V(8); PG8_WAIT_L(0); PG8_BAR; PG8_MMA(0, 0, At, B0); PG8_MMA(0, 1, At, B1); PG8_BAR; PG8_SCHED;
            PG8_LDA(At, 0, 1); PG8_STAGE(PG8_SB(0, 0), b2, voffB); PG8_STAGE(PG8_SB(0, 1), b2 + hstep, voffB); PG8_STAGE(PG8_SA(0, 0), a2, vc0);
            PG8_WAIT_V(8); PG8_WAIT_L(0); PG8_BAR; PG8_MMA(1, 0, At, B0); PG8_MMA(1, 1, At, B1); PG8_BAR; PG8_SCHED;
            PG8_LDB(B0, 1, 0); PG8_LDB(B1, 1, 1); PG8_SCHED; PG8_LDA(At, 1, 0); PG8_STAGE_A1(PG8_SA(0, 1), a2);
            PG8_WAIT_V(8); PG8_WAIT_L(0); PG8_BAR; PG8_MMA(0, 0, At, B0); PG8_MMA(0, 1, At, B1); PG8_BAR; PG8_SCHED;
            PG8_LDA(At, 1, 1); PG8_STAGE(PG8_SB(1, 0), b3, voffB); PG8_STAGE(PG8_SB(1, 1), b3 + hstep, voffB); PG8_STAGE(PG8_SA(1, 0), a3, vc0);
            PG8_WAIT_V(8); PG8_WAIT_L(0); PG8_BAR; PG8_MMA(1, 0, At, B0); PG8_MMA(1, 1, At, B1); PG8_BAR; PG8_SCHED;
        }
        if constexpr (ALIGN_EPI) { if (wr == 0) PG8_BAR; }
        { const int lo_ = opaque_tid() & 63; E(acc, cur, wr, wc, lo_ & 15, lo_ >> 4); }
        if (!has_next) break;
#pragma unroll
        for (int a = 0; a < 2; ++a)
#pragma unroll
            for (int b = 0; b < 2; ++b)
#pragma unroll
                for (int m = 0; m < 4; ++m)
#pragma unroll
                    for (int n = 0; n < 2; ++n) acc[a][b][m][n] = (f32x4){0.f, 0.f, 0.f, 0.f};
        cur = nxt; cB = nB; ++ui;
        if constexpr (ALIGN_EPI) { if (wr == 1) PG8_BAR; }
    }
    PG8_WAIT_V(0);
    if constexpr (!ALIGN_EPI) { if (wr == 0) PG8_BAR; }
    PG8_BAR;
#undef aoff
#undef boff
#undef PG8_SA
#undef PG8_SB
#undef PG8_STAGE
#undef PG8_STAGE_A1
#undef PG8_LDA
#undef PG8_LDB
#undef PG8_MMA
#undef PG8_WAIT_V
#undef PG8_WAIT_L
#undef PG8_BAR
#undef PG8_SCHED
}
struct MoeOrder {
    const PG8_LAS unsigned* tab; int npn, vcu, G; const int* rowtok; const bf16_t* Bt; size_t bstride  ; int K; bool gather; int rep  ; const int* ident; const int* zero_word;
    __device__ __forceinline__ bool next(int i, GUnit& u) const {
        const unsigned w = tab[384 + i]; if (w == ~0u) return false; u.e = (int)(w >> 16); u.rb = (int)((w >> 4) & 0xfffu); u.pn = (int)(w & 15u); return true;
    }
    __device__ __forceinline__ unsigned unit_at(int i) const {
        int L = i * G + vcu; const int total = (int)tab[256 + NE_P1] * npn; if (L >= total * rep) return ~0u; if (L >= total) L -= total;
        const int tile = L / npn; const int pn = L - tile * npn;
        int lo = 0, hi = NE_P1;
        while (hi - lo > 1) { const int mid = (lo + hi) >> 1; if ((int)tab[256 + mid] <= tile) lo = mid; else hi = mid; }
        return ((unsigned)lo << 16) | ((unsigned)(tile - (int)tab[256 + lo]) << 4) | (unsigned)pn;
    }
    __device__ __forceinline__ unsigned arow_off(const GUnit& u, int R) const {
        const int r = u.rb * 256 + R;
        if (gather) { int idx = r; if (u.e < NE_P1 - 1) idx = (r < (int)tab[128 + u.e]) ? rowtok[u.e * ECAP_ + r] : 0; return (unsigned)idx * (unsigned)(K * 2); }
        return ((unsigned)tab[u.e] + (unsigned)r) * (unsigned)(K * 2);
    }
    __device__ __forceinline__ const int* row_ptr(const GUnit& u, int R) const { const int r = u.rb * 256 + R; if (u.e == NE_P1 - 1) return ident + r; return (r < (int)tab[128 + u.e]) ? rowtok + u.e * ECAP_ + r : zero_word; }
    __device__ __forceinline__ const char* bbase(const GUnit& u) const { return (const char*)(Bt + (size_t)u.e * bstride + (size_t)u.pn * 256 * K); }
};
__device__ __forceinline__ f32x4 silu_mul(f32x4 g, f32x4 u) { f32x4 r;
#pragma unroll
    for (int i = 0; i < 4; ++i) r[i] = g[i] * __builtin_amdgcn_rcpf(1.f + __expf(-g[i])) * u[i];
    return r; }
struct EpiUpG {
    static constexpr bool PERM = true, AFTER_DRAIN = false;
    unsigned char* act8; const PG8_LAS unsigned* tab; float wscale, ascale;
    __device__ __forceinline__ void operator()(const f32x4 (&acc)[2][2][4][2], const GUnit& u, int wr, int wc, int fr, int fq) const {
        const int n = (int)tab[128 + u.e]; const size_t base = tab[u.e]; const float rs = wscale;
#pragma unroll
        for (int ai = 0; ai < 2; ++ai)
#pragma unroll
            for (int m = 0; m < 4; ++m) { const int r = u.rb * 256 + ai * HALF + wr * 64 + m * 16 + fr;
                if (r < n) {
                    const f32x4 a0 = silu_mul(acc[ai][0][m][0] * rs, acc[ai][1][m][0] * rs) * ascale, a1 = silu_mul(acc[ai][0][m][1] * rs, acc[ai][1][m][1] * rs) * ascale;
                    int lo = __builtin_amdgcn_cvt_pk_fp8_f32(a0[0], a0[1], 0, false); lo = __builtin_amdgcn_cvt_pk_fp8_f32(a0[2], a0[3], lo, true);
                    int hi = __builtin_amdgcn_cvt_pk_fp8_f32(a1[0], a1[1], 0, false); hi = __builtin_amdgcn_cvt_pk_fp8_f32(a1[2], a1[3], hi, true);
                    typedef int i32x2 __attribute__((ext_vector_type(2))); *(i32x2*)(act8 + (base + r) * 256 + u.pn * 128 + wc * 32 + 8 * fq) = (i32x2){lo, hi}; } }
    }
};
struct EpiDownG {
    static constexpr bool PERM = true, AFTER_DRAIN = false;
    unsigned char* yb; float* out; const PG8_LAS unsigned* tab; float yscale;
    __device__ __forceinline__ void operator()(const f32x4 (&acc)[2][2][4][2], const GUnit& u, int wr, int wc, int fr, int fq) const {
        const int n = (int)tab[128 + u.e]; const size_t base = tab[u.e]; const int col0 = u.pn * 256 + wc * 32 + 8 * fq;
#pragma unroll
        for (int ai = 0; ai < 2; ++ai)
#pragma unroll
            for (int m = 0; m < 4; ++m) { const int r = u.rb * 256 + ai * HALF + wr * 64 + m * 16 + fr;
                if (r < n) {
#pragma unroll
                        for (int bj = 0; bj < 2; ++bj) { const f32x4 a = acc[ai][bj][m][0] * yscale, b = acc[ai][bj][m][1] * yscale;
                            int lo = __builtin_amdgcn_cvt_pk_fp8_f32(a[0], a[1], 0, false); lo = __builtin_amdgcn_cvt_pk_fp8_f32(a[2], a[3], lo, true);
                            int hi = __builtin_amdgcn_cvt_pk_fp8_f32(b[0], b[1], 0, false); hi = __builtin_amdgcn_cvt_pk_fp8_f32(b[2], b[3], hi, true);
                            typedef int i32x2 __attribute__((ext_vector_type(2)));
                            *(i32x2*)(yb + (base + r) * 1024 + col0 + bj * HALF) = (i32x2){lo, hi}; }
                    } }
    }
};
}

namespace attn_body {
using bf16=__hip_bfloat16;
using bf16x8=__attribute__((ext_vector_type(8)))short;
using s16x4=__attribute__((ext_vector_type(4)))short;
using f32x16=__attribute__((ext_vector_type(16)))float;
using u32x4=__attribute__((ext_vector_type(4)))unsigned;
constexpr int BATCH=4,NHEAD=16,SEQ=4096,D=64,QP=512,KP=512,VP=512,OP=1024;
constexpr int NW=8,QBLK=32,QB=QBLK*NW,KVBLK=64,NQB=SEQ/QB;
constexpr int ATTN_UNIT_ROWS=QB;
__device__ __forceinline__ int crow(int r,int hi){return (r&3)+8*(r>>2)+4*hi;}
#define SBAR() __builtin_amdgcn_sched_barrier(0)
__device__ __forceinline__ void cmask(f32x16&p0,f32x16&p1,int jb,int qrel,int hi){
  const float NEG=-INFINITY; int kb=64*jb+4*hi;
  #pragma unroll
  for(int r=0;r<16;++r){int kv=kb+(r&3)+8*(r>>2); if(kv>qrel)p0[r]=NEG; if(kv+32>qrel)p1[r]=NEG;}
}

constexpr int NSLOT=3, SLOTB=8192;
constexpr int LDS_K=0, LDS_V=NSLOT*SLOTB, LDS_WS=2*NSLOT*SLOTB, LDS_OST=LDS_WS+NW*64*4, LDS_BYTES=LDS_OST+NW*4096;
constexpr float C2=0.125f*1.4426950408889634f;
__device__ __forceinline__ void glds16(const void*gsrc,unsigned lds_dst){unsigned keep;
  asm volatile("s_mov_b32 %0, m0\n\ts_mov_b32 m0, %2\n\ts_nop 0\n\tglobal_load_lds_dwordx4 %1, off\n\ts_mov_b32 m0, %0":"=&s"(keep):"v"(gsrc),"s"(lds_dst):"memory");}
__device__ __forceinline__ float max3f(float a,float b,float c){float r;asm("v_max3_f32 %0, %1, %2, %3":"=v"(r):"v"(a),"v"(b),"v"(c));return r;}
__device__ __forceinline__ float max2f(float a,float b){float r;asm("v_max_f32_e32 %0, %1, %2":"=v"(r):"v"(a),"v"(b));return r;}
__device__ __forceinline__ float fadd_s(float a,float b){float r;asm("v_add_f32_e32 %0, %1, %2":"=v"(r):"v"(a),"v"(b));return r;}
__device__ __forceinline__ float fsub_s(float a,float b){float r;asm("v_sub_f32_e32 %0, %1, %2":"=v"(r):"v"(a),"v"(b));return r;}
typedef float f32x2_t __attribute__((ext_vector_type(2))); typedef __bf16 bf16x2_t __attribute__((ext_vector_type(2)));
__device__ __forceinline__ unsigned cvtpk_s(float lo,float hi){f32x2_t v={lo,hi};bf16x2_t b=__builtin_convertvector(v,bf16x2_t);return __builtin_bit_cast(unsigned,b);}
#define WAIT_BAR(N) asm volatile("s_waitcnt vmcnt(" #N ") lgkmcnt(0)\n\ts_barrier":::"memory")

__device__ __forceinline__ void qkt(f32x16&p0,f32x16&p1,const char*Kslot,const bf16x8*qr,const f32x16&negm,int r32,int hi){
  const char*kb=Kslot+hi*1024+r32*16;
  #pragma unroll
  for(int d0=0;d0<4;++d0){
    const bf16x8 b0=*reinterpret_cast<const bf16x8*>(kb+d0*2048);
    const bf16x8 b1=*reinterpret_cast<const bf16x8*>(kb+d0*2048+512);
    if(d0==0){p0=__builtin_amdgcn_mfma_f32_32x32x16_bf16(b0,qr[0],negm,0,0,0);p1=__builtin_amdgcn_mfma_f32_32x32x16_bf16(b1,qr[0],negm,0,0,0);}
    else{p0=__builtin_amdgcn_mfma_f32_32x32x16_bf16(b0,qr[d0],p0,0,0,0);p1=__builtin_amdgcn_mfma_f32_32x32x16_bf16(b1,qr[d0],p1,0,0,0);}}
}
typedef __attribute__((address_space(3))) const char* lds_cptr;
typedef short v4i16_t __attribute__((ext_vector_type(4)));
__device__ __forceinline__ void kload8(bf16x8*kf,lds_cptr kp){
  kf[0]=*(const __attribute__((address_space(3))) bf16x8*)(kp);      kf[1]=*(const __attribute__((address_space(3))) bf16x8*)(kp+512);
  kf[2]=*(const __attribute__((address_space(3))) bf16x8*)(kp+2048); kf[3]=*(const __attribute__((address_space(3))) bf16x8*)(kp+2560);
  kf[4]=*(const __attribute__((address_space(3))) bf16x8*)(kp+4096); kf[5]=*(const __attribute__((address_space(3))) bf16x8*)(kp+4608);
  kf[6]=*(const __attribute__((address_space(3))) bf16x8*)(kp+6144); kf[7]=*(const __attribute__((address_space(3))) bf16x8*)(kp+6656);
}
__device__ __forceinline__ void kload2(bf16x8*kf,lds_cptr kp,int j){ kf[2*j]=*(const __attribute__((address_space(3))) bf16x8*)(kp+j*2048); kf[2*j+1]=*(const __attribute__((address_space(3))) bf16x8*)(kp+j*2048+512); }
__device__ __forceinline__ s16x4 vtr(lds_cptr p){ return __builtin_bit_cast(s16x4,__builtin_amdgcn_ds_read_tr16_b64_v4i16((__attribute__((address_space(3))) v4i16_t*)p)); }
__device__ __forceinline__ float rowmax(const f32x16&p0,const f32x16&p1){
  float a=max3f(p0[0],p0[1],p1[0]),b=max3f(p0[2],p0[3],p1[1]);a=max3f(a,p1[2],p1[3]);
  #pragma unroll
  for(int r=4;r<16;r+=4){a=max3f(a,p0[r],p0[r+1]);b=max3f(b,p0[r+2],p0[r+3]);a=max3f(a,p1[r],p1[r+1]);b=max3f(b,p1[r+2],p1[r+3]);}
  const float m=max2f(a,b);
  auto rr=__builtin_amdgcn_permlane32_swap(__float_as_uint(m),__float_as_uint(m),false,false);
  return max2f(__uint_as_float(rr[0]),__uint_as_float(rr[1]));
}
__device__ __forceinline__ void pv(f32x16*o,int vb,bf16x8 pa0,bf16x8 pa1,bf16x8 pa2,bf16x8 pa3){
  #pragma unroll
  for(int d0=0;d0<2;++d0){s16x4 lo[4],hi[4];
    #pragma unroll
    for(int ks=0;ks<4;++ks){
      asm volatile("ds_read_b64_tr_b16 %0,%1 offset:%c2":"=&v"(lo[ks]):"v"(vb),"i"(d0*4096+ks*1024):"memory");
      asm volatile("ds_read_b64_tr_b16 %0,%1 offset:%c2":"=&v"(hi[ks]):"v"(vb),"i"(d0*4096+ks*1024+512):"memory");}
    asm volatile("s_waitcnt lgkmcnt(0)":::"memory");SBAR();
    #define PK(k) (bf16x8){lo[k][0],lo[k][1],lo[k][2],lo[k][3],hi[k][0],hi[k][1],hi[k][2],hi[k][3]}
    o[d0]=__builtin_amdgcn_mfma_f32_32x32x16_bf16(pa0,PK(0),o[d0],0,0,0);
    o[d0]=__builtin_amdgcn_mfma_f32_32x32x16_bf16(pa1,PK(1),o[d0],0,0,0);
    o[d0]=__builtin_amdgcn_mfma_f32_32x32x16_bf16(pa2,PK(2),o[d0],0,0,0);
    o[d0]=__builtin_amdgcn_mfma_f32_32x32x16_bf16(pa3,PK(3),o[d0],0,0,0);
    #undef PK
  }
}

#ifndef ATTN_STORE16
#define ATTN_STORE16(p,v) (*(u32x4*)(p)=(v))
#endif
template<int THRL> __device__ __forceinline__ void attn_unit(int b,int h,int qb,const bf16*Q,const bf16*__restrict__ K,const bf16*__restrict__ V,bf16*O,char*shm){
  const int tid=opaque_tid(),lane=tid&63,r32=lane&31,hi=lane>>5; const int wid=__builtin_amdgcn_readfirstlane(tid>>6);
  const long rowbase=(long)b*SEQ; const int q0=qb*QB;
  const int h4=h>>2,hc=h>>1,vhalf=h&1; const bf16*Qw=Q+(rowbase+q0+wid*QBLK)*QP+hc*D;
  const bf16*Kh=K+rowbase*KP+hc*D,*Vh=V+rowbase*VP+h4*128+vhalf*D;
  const unsigned lds0=(unsigned)(uintptr_t)shm;
  float*wsf=(float*)(shm+LDS_WS)+wid*64;
  const bf16*ksrc=Kh+(long)lane*KP+wid*8;
  const bf16*vsrc=Vh+(long)(16*(wid&3)+(lane>>2))*VP+(wid>>2)*32+(lane&3)*8;
  const unsigned kdst=lds0+LDS_K+wid*1024, vdst=lds0+LDS_V+wid*1024;
  #define DMA_K(t,slot) glds16(ksrc+(long)(t)*KVBLK*KP,(unsigned)__builtin_amdgcn_readfirstlane(kdst+(slot)))
  #define DMA_V(t,slot) glds16(vsrc+(long)(t)*KVBLK*VP,(unsigned)__builtin_amdgcn_readfirstlane(vdst+(slot)))
  const int vb0=(int)(lds0+LDS_V)+((lane>>4)&1)*32+(lane&3)*8+(4*hi+((lane&15)>>2))*64;
  const char*Kbase=shm+LDS_K; bf16x8 kf[8];
  const lds_cptr shm3=(lds_cptr)shm; const lds_cptr kp0=shm3+LDS_K+hi*1024+r32*16; const lds_cptr vp0=shm3+LDS_V+((lane>>4)&1)*32+(lane&3)*8+(4*hi+((lane&15)>>2))*64;
  const int NT=(q0+QB)/KVBLK;
  DMA_K(0,0);DMA_V(0,0);DMA_K(1,SLOTB);
  bf16x8 qr[4];
  #pragma unroll
  for(int d0=0;d0<4;++d0)qr[d0]=*reinterpret_cast<const bf16x8*>(&Qw[(long)r32*QP+d0*16+hi*8]);
  float mhat=0.f,l_reg=0.f;f32x16 o[2];o[0]=f32x16{};o[1]=f32x16{};f32x16 negm=f32x16{};asm volatile("":"+v"(negm));
  const int qrel=wid*QBLK+r32;
  #define CMASK(P0,P1,t) do{int jb_=(t)-(NT-4); if(jb_>=0)cmask(P0,P1,jb_,qrel,hi);}while(0)
  bool resc=false;
  #define START(P0,P1) do{ const float rm=rowmax(P0,P1); resc=false; \
    { const float dl=rm; mhat=fadd_s(mhat,dl); \
      _Pragma("unroll") for(int r=0;r<16;++r){P0[r]=fsub_s(P0[r],dl);P1[r]=fsub_s(P1[r],dl);} \
      _Pragma("unroll") for(int r=0;r<16;++r)negm[r]=-mhat; asm volatile("":"+v"(negm)); } \
    _Pragma("unroll") for(int r=0;r<16;++r)P0[r]=__builtin_amdgcn_exp2f(P0[r]); }while(0)
  #define RESC() do{ if(resc){ asm volatile("s_waitcnt lgkmcnt(0)":::"memory"); \
      _Pragma("unroll") for(int d_=0;d_<2;++d_) _Pragma("unroll") for(int r=0;r<16;++r)o[d_][r]*=wsf[crow(r,hi)]; } }while(0)
  f32x16 pA0,pA1,pB0,pB1;
  int sl_prev=0,sl_cur=0,sl_next=SLOTB;
  #define ROT() do{sl_prev=sl_cur;sl_cur=sl_next;sl_next=(sl_next==(NSLOT-1)*SLOTB)?0:sl_next+SLOTB;}while(0)
  DMA_K(2,2*SLOTB);
  WAIT_BAR(3);
  qkt(pA0,pA1,Kbase,qr,negm,r32,hi);asm volatile("s_nop 15\n\ts_nop 7":"+v"(pA0),"+v"(pA1));CMASK(pA0,pA1,0);
  START(pA0,pA1);
  _Pragma("unroll") for(int r=0;r<16;++r)pA1[r]=__builtin_amdgcn_exp2f(pA1[r]);
  WAIT_BAR(0);
  DMA_K(3,0);DMA_V(1,SLOTB);
  ROT();
  kload8(kf,kp0+sl_cur);
  WAIT_BAR(2);
  s16x4 vlo[8],vhi[8]; u32x4 pw0,pw1,pw2,pw3;
  #define PKW(P,B) cvtpk_s(P[B],P[B+1])
  #define PAF(k) __builtin_bit_cast(bf16x8,pw##k)
  #define VFR(i) (bf16x8){vlo[i][0],vlo[i][1],vlo[i][2],vlo[i][3],vhi[i][0],vhi[i][1],vhi[i][2],vhi[i][3]}
  #define PIN(x) asm volatile("":"+v"(x))
  #define MX3(a,b,c) __builtin_fmaxf(__builtin_fmaxf((a),(b)),(c))
  #define GAPA(MF,A0,A1,A2,A3,W0,W1,PW) do{ MF; sacc+=A0; sacc+=A1; sacc+=A2; sacc+=A3; PIN(sacc); W0; W1; PIN(PW); SBAR(); }while(0)
  #define EX(v) __builtin_amdgcn_exp2f(v)
  #define GAPB(MF,X,B) do{ MF; X[B]=EX(X[B]); X[B+1]=EX(X[B+1]); X[B+2]=EX(X[B+2]); X[B+3]=EX(X[B+3]); PIN(X); SBAR(); }while(0)
  #define VRD(i) do{ vlo[i]=vtr(vp_+(((i)>>2)*4096+((i)&3)*1024)); vhi[i]=vtr(vp_+(((i)>>2)*4096+((i)&3)*1024+512)); }while(0)
  #define KRD(G,j) do{ if(G){ kload2(kf,kp0+sl_next,j); SBAR(); } }while(0)
  #define STEP(C0,C1,P0,P1,t,GK,GV,GL) do{ SBAR(); \
    const lds_cptr vp_=vp0+sl_prev; \
    VRD(0); SBAR(); float sacc=(P0[0]+P0[1]); \
    GAPA(C0=__builtin_amdgcn_mfma_f32_32x32x16_bf16(kf[0],qr[0],negm,0,0,0), P0[2],P0[3],P0[4],P0[5],     pw0[0]=PKW(P0,0), pw0[1]=PKW(P0,2), pw0); \
    VRD(4); SBAR(); GAPA(C1=__builtin_amdgcn_mfma_f32_32x32x16_bf16(kf[1],qr[0],negm,0,0,0), P0[6],P0[7],P0[8],P0[9],     pw0[2]=PKW(P0,4), pw0[3]=PKW(P0,6), pw0); \
    VRD(1); SBAR(); GAPA(C0=__builtin_amdgcn_mfma_f32_32x32x16_bf16(kf[2],qr[1],C0,0,0,0),   P0[10],P0[11],P0[12],P0[13], pw1[0]=PKW(P0,8), pw1[1]=PKW(P0,10), pw1); \
    VRD(5); SBAR(); GAPA(C1=__builtin_amdgcn_mfma_f32_32x32x16_bf16(kf[3],qr[1],C1,0,0,0),   P0[14],P0[15],P1[0],P1[1],   pw1[2]=PKW(P0,12),pw1[3]=PKW(P0,14), pw1); \
    VRD(2); SBAR(); GAPA(C0=__builtin_amdgcn_mfma_f32_32x32x16_bf16(kf[4],qr[2],C0,0,0,0),   P1[2],P1[3],P1[4],P1[5],     pw2[0]=PKW(P1,0), pw2[1]=PKW(P1,2), pw2); \
    VRD(6); SBAR(); GAPA(C1=__builtin_amdgcn_mfma_f32_32x32x16_bf16(kf[5],qr[2],C1,0,0,0),   P1[6],P1[7],P1[8],P1[9],     pw2[2]=PKW(P1,4), pw2[3]=PKW(P1,6), pw2); \
    VRD(3); SBAR(); GAPA(C0=__builtin_amdgcn_mfma_f32_32x32x16_bf16(kf[6],qr[3],C0,0,0,0),   P1[10],P1[11],P1[12],P1[13], pw3[0]=PKW(P1,8), pw3[1]=PKW(P1,10), pw3); \
    VRD(7); SBAR(); GAPA(C1=__builtin_amdgcn_mfma_f32_32x32x16_bf16(kf[7],qr[3],C1,0,0,0),   P1[14],P1[15],0.f,0.f,       pw3[2]=PKW(P1,12),pw3[3]=PKW(P1,14), pw3); \
    l_reg+=sacc; \
    if(GK){DMA_K((t)+3,sl_cur);} if(GV){DMA_V((t)+1,sl_next);} \
    CMASK(C0,C1,t); \
    { float a=MX3(C0[0],C0[1],C1[0]),b=MX3(C0[2],C0[3],C1[1]); a=MX3(a,C1[2],C1[3]); \
      _Pragma("unroll") for(int r=4;r<16;r+=4){a=MX3(a,C0[r],C0[r+1]);b=MX3(b,C0[r+2],C0[r+3]);a=MX3(a,C1[r],C1[r+1]);b=MX3(b,C1[r+2],C1[r+3]);} \
      float rm=__builtin_fmaxf(a,b); { auto rr=__builtin_amdgcn_permlane32_swap(__float_as_uint(rm),__float_as_uint(rm),false,false); rm=__builtin_fmaxf(__uint_as_float(rr[0]),__uint_as_float(rr[1])); } \
      resc=false; \
      if(__builtin_expect(__any(rm>(float)THRL),0)){ const float dl=__builtin_fmaxf(rm,0.f); mhat+=dl; \
        _Pragma("unroll") for(int r=0;r<16;++r){C0[r]-=dl;C1[r]-=dl;} \
        _Pragma("unroll") for(int r=0;r<16;++r)negm[r]=-mhat; asm volatile("":"+v"(negm)); \
        const float f=__builtin_amdgcn_exp2f(-dl); l_reg*=f; if(hi==0)wsf[r32]=f; resc=true; } } \
    SBAR(); \
    GAPB(o[0]=__builtin_amdgcn_mfma_f32_32x32x16_bf16(PAF(0),VFR(0),o[0],0,0,0), C0,0); \
    GAPB(o[1]=__builtin_amdgcn_mfma_f32_32x32x16_bf16(PAF(0),VFR(4),o[1],0,0,0), C0,4); \
    KRD(GL,0); GAPB(o[0]=__builtin_amdgcn_mfma_f32_32x32x16_bf16(PAF(1),VFR(1),o[0],0,0,0), C0,8); \
    KRD(GL,1); GAPB(o[1]=__builtin_amdgcn_mfma_f32_32x32x16_bf16(PAF(1),VFR(5),o[1],0,0,0), C0,12); \
    KRD(GL,2); GAPB(o[0]=__builtin_amdgcn_mfma_f32_32x32x16_bf16(PAF(2),VFR(2),o[0],0,0,0), C1,0); \
    KRD(GL,3); GAPB(o[1]=__builtin_amdgcn_mfma_f32_32x32x16_bf16(PAF(2),VFR(6),o[1],0,0,0), C1,4); \
    GAPB(o[0]=__builtin_amdgcn_mfma_f32_32x32x16_bf16(PAF(3),VFR(3),o[0],0,0,0), C1,8); \
    GAPB(o[1]=__builtin_amdgcn_mfma_f32_32x32x16_bf16(PAF(3),VFR(7),o[1],0,0,0), C1,12); \
    }while(0)
  int t=1;
  #undef CMASK
  #define CMASK(P0,P1,t) do{}while(0)
  for(;t+5<NT;t+=2){
    STEP(pB0,pB1,pA0,pA1,t,true,true,true);     WAIT_BAR(2); RESC(); ROT();
    STEP(pA0,pA1,pB0,pB1,t+1,true,true,true);   WAIT_BAR(2); RESC(); ROT();
  }
  #undef CMASK
  #define CMASK(P0,P1,t) do{int jb_=(t)-(NT-4); if(jb_>=0)cmask(P0,P1,jb_,qrel,hi);}while(0)
  #define ENDW(tt) do{ if((tt)+3<NT){WAIT_BAR(2);} else if((tt)+2<NT){WAIT_BAR(1);} else {WAIT_BAR(0);} }while(0)
  for(;t+1<NT;t+=2){
    STEP(pB0,pB1,pA0,pA1,t,(t+3<NT),(t+1<NT),(t+1<NT));       ENDW(t);   RESC(); ROT();
    STEP(pA0,pA1,pB0,pB1,t+1,(t+4<NT),(t+2<NT),(t+2<NT));     ENDW(t+1); RESC(); ROT();
  }
  STEP(pB0,pB1,pA0,pA1,NT-1,false,false,false); RESC();
  { float sacc=pB0[0]+pB0[1]; _Pragma("unroll") for(int r=2;r<16;++r)sacc+=pB0[r]; _Pragma("unroll") for(int r=0;r<16;++r)sacc+=pB1[r]; l_reg+=sacc;
    pw0=(u32x4){PKW(pB0,0),PKW(pB0,2),PKW(pB0,4),PKW(pB0,6)};pw1=(u32x4){PKW(pB0,8),PKW(pB0,10),PKW(pB0,12),PKW(pB0,14)};pw2=(u32x4){PKW(pB1,0),PKW(pB1,2),PKW(pB1,4),PKW(pB1,6)};pw3=(u32x4){PKW(pB1,8),PKW(pB1,10),PKW(pB1,12),PKW(pB1,14)};
    SBAR(); pv(o,vb0+sl_cur,PAF(0),PAF(1),PAF(2),PAF(3)); }
  #undef PKW
  #undef PAF
  #undef VFR
  #undef PIN
  #undef MX3
  #undef GAPA
  #undef GAPB
  #undef EX
  #undef VRD
  #undef KRD
  #undef STEP
  #undef ENDW
  {auto rr=__builtin_amdgcn_permlane32_swap(__float_as_uint(l_reg),__float_as_uint(l_reg),false,false);l_reg=__uint_as_float(rr[0])+__uint_as_float(rr[1]);}
  if(hi==0)wsf[32+r32]=l_reg;asm volatile("s_waitcnt lgkmcnt(0)":::"memory");
  float rli[16];
  #pragma unroll
  for(int r=0;r<16;++r)rli[r]=__builtin_amdgcn_rcpf(wsf[32+crow(r,hi)]);
  bf16*Ow=O+(rowbase+q0+wid*QBLK)*OP+h*D;
  { bf16*stg=(bf16*)(shm+LDS_OST)+wid*2048;
    #pragma unroll
    for(int r=0;r<16;++r){const int orow=crow(r,hi);
      #pragma unroll
      for(int d0=0;d0<2;++d0)stg[orow*64+d0*32+r32]=__float2bfloat16(o[d0][r]*rli[r]);}
    asm volatile("s_waitcnt lgkmcnt(0)":::"memory");
    #pragma unroll
    for(int i=0;i<4;++i){const int row=i*8+(lane>>3),ch=lane&7; const u32x4 v=*(const u32x4*)(stg+row*64+ch*8); ATTN_STORE16(Ow+(long)row*OP+ch*8,v);} }
  asm volatile("s_waitcnt lgkmcnt(0)\n\ts_barrier":::"memory");
  #undef DMA_K
  #undef DMA_V
  #undef CMASK
  #undef START
  #undef RESC
  #undef ROT
}
constexpr int ATTN_LDS_BYTES=LDS_BYTES;
struct AttnTensors { const bf16* Q; const bf16* K; const bf16* V; bf16* O; };
struct AttnUnit { int bh; int qb; };
struct StaticOrder {
  int vcu,G;
  __device__ __forceinline__ explicit StaticOrder(int grid,int block):vcu((grid%8==0)?(block%8)*(grid/8)+block/8:block),G(grid){}
  __device__ __forceinline__ bool next(int i,AttnUnit&u)const{
    if(G==256){ if(i>=4)return false; const int s=vcu&3; u.bh=vcu>>2; u.qb=(i==0)?s:(i==1)?7-s:(i==2)?8+s:15-s; return true; }
    const int L=i*G+vcu; if(L>=BATCH*NHEAD*NQB)return false; u.bh=L/NQB; u.qb=L%NQB; return true; }
  __device__ __forceinline__ void a_ready(const AttnUnit&)const{}
  __device__ __forceinline__ void done(const AttnUnit&)const{}
};
template<class Sched,int THRL=8> __device__ __forceinline__ void attn_phase(char*lds,const AttnTensors&T,const Sched&S){
  AttnUnit u;
  for(int i=0;S.next(i,u);++i){ S.a_ready(u); attn_unit<THRL>(u.bh/NHEAD,u.bh%NHEAD,u.qb,T.Q,T.K,T.V,T.O,lds); S.done(u); }
}
#undef SBAR
#undef WAIT_BAR
}

constexpr int CW_PANEL = 8192;
__device__ __forceinline__ void panel_barrier(unsigned* ctl, int stage, int pm) {
    asm volatile("s_waitcnt vmcnt(0)" ::: "memory");
    __syncthreads();
    if (opaque_tid() == 0) {
        unsigned* w = ctl + CW_PANEL + (stage * 64 + pm) * 64; unsigned* tmo = ctl + CW_BAR + XB_TMO;
        __builtin_amdgcn_fence(__ATOMIC_RELEASE, "agent");
        asm volatile("s_waitcnt vmcnt(0)" ::: "memory");
        (void)xb_add(w, 1u);
        unsigned sp = 0u;
        while (xb_ld(w) < 4u) { __builtin_amdgcn_s_sleep(1); if ((++sp & 255u) == 0u) { if (xb_ld(tmo)) break; if (sp > XB_SPIN_CAP) { atomicAdd(tmo, 1u); break; } } }
        __builtin_amdgcn_fence(__ATOMIC_ACQUIRE, "agent");
        asm volatile("s_waitcnt vmcnt(0)" ::: "memory");
    }
    __syncthreads();
}
namespace pg8 {
struct EpiGateFinal {
    static constexpr bool PERM = true, AFTER_DRAIN = true;
    float* out; const bf16_t* h2b; const bf16_t* pp; float cs; const float* ln_f; float* xs  ; unsigned* ctl;
    __device__ __forceinline__ void fused(f32x4 (&acc)[2][2][4][2], const Unit& u, int wr, int wc, int fr, int fq, PG8_LAS unsigned char* lds, int wid, int lane) const {
        PG8_LAS float* P = (PG8_LAS float*)lds;
        PG8_LAS float* S = (PG8_LAS float*)(lds + 4096);
        const int row0 = u.pm * BM + wr * 64 + fr, col0 = u.pn * BM + wc * 32 + 8 * fq;
#pragma unroll
        for (int ai = 0; ai < 2; ++ai)
#pragma unroll
            for (int m = 0; m < 4; ++m) { const int row = row0 + ai * HALF + m * 16; const float rs = cs; const size_t off = (size_t)row * 1024 + col0; float ssq = 0.f;
#pragma unroll
                for (int bj = 0; bj < 2; ++bj) { f32x4 g0, g1, q0, q1; unpack8(*(const u32x4*)(pp + off + bj * HALF), g0, g1); unpack8(*(const u32x4*)(h2b + off + bj * HALF), q0, q1);
                    const f32x4 a = q0 + sig4(acc[ai][bj][m][0] * rs) * g0, b = q1 + sig4(acc[ai][bj][m][1] * rs) * g1; acc[ai][bj][m][0] = a; acc[ai][bj][m][1] = b;
                    ssq += (a[0] * a[0] + a[1] * a[1]) + (a[2] * a[2] + a[3] * a[3]) + (b[0] * b[0] + b[1] * b[1]) + (b[2] * b[2] + b[3] * b[3]); }
                asm volatile("" : "+v"(acc[ai][0][m][0]), "+v"(acc[ai][0][m][1]), "+v"(acc[ai][1][m][0]), "+v"(acc[ai][1][m][1]));
                ssq += __shfl_xor(ssq, 16); ssq += __shfl_xor(ssq, 32);
                if (fq == 0) P[(ai * HALF + wr * 64 + m * 16 + fr) * 4 + wc] = ssq; }
        asm volatile("s_waitcnt lgkmcnt(0)" ::: "memory"); __builtin_amdgcn_s_barrier(); asm volatile("" ::: "memory");
        const int tid = wid * 64 + lane;
        if (tid < 256) xs[((size_t)u.pm * 256 + tid) * 4 + u.pn] = (P[tid * 4 + 0] + P[tid * 4 + 1]) + (P[tid * 4 + 2] + P[tid * 4 + 3]);
        panel_barrier(ctl, 3, u.pm);
        if (tid < 256) { const f32x4 t = *(const f32x4*)(xs + ((size_t)u.pm * 256 + tid) * 4); S[tid] = rsqrtf(((t[0] + t[1]) + (t[2] + t[3])) * (1.f / 1024.f) + 1e-6f); }
        asm volatile("s_waitcnt lgkmcnt(0)" ::: "memory"); __builtin_amdgcn_s_barrier(); asm volatile("" ::: "memory");
        f32x4 lf[2][2];
#pragma unroll
        for (int bj = 0; bj < 2; ++bj) { lf[bj][0] = *(const f32x4*)(ln_f + col0 + bj * HALF); lf[bj][1] = *(const f32x4*)(ln_f + col0 + bj * HALF + 4); }
#pragma unroll
        for (int ai = 0; ai < 2; ++ai)
#pragma unroll
            for (int m = 0; m < 4; ++m) { const int rl = ai * HALF + wr * 64 + m * 16 + fr; const float rstd = S[rl]; float* o = out + (size_t)(u.pm * BM + rl) * 1024 + col0;
#pragma unroll
                for (int bj = 0; bj < 2; ++bj) { *(f32x4*)(o + bj * HALF) = acc[ai][bj][m][0] * rstd * lf[bj][0]; *(f32x4*)(o + bj * HALF + 4) = acc[ai][bj][m][1] * rstd * lf[bj][1]; } }
    }
};
}
namespace pg8 {
struct PanelOrder { int v; __device__ __forceinline__ bool next(int i, Unit& u) const { if (i > 0) return false; u.pm = v >> 2; u.pn = v & 3; return true; }
    __device__ __forceinline__ void a_ready(const Unit&) const {} __device__ __forceinline__ void done(const Unit&) const {} };
}
struct Args { const void* in[32]; float* out; unsigned char* ws; int ph_lo, ph_hi; };
struct Ctx {
    unsigned char* lds;
    int tid, lane, wave, bid, G, vcu;
    const float *x, *p; const int* positions;
    const float *ln_mix, *w_in, *conv_w, *conv_b, *w_a, *b_a, *w_i, *b_i, *rg_lambda, *g_rec, *lq1, *lk1, *lq2, *lk2, *g_sub, *w_out, *ln_moe, *w_router, *e_bias, *w1, *w3, *w2, *ws1, *ws3, *ws2, *ln_ple, *w_pg, *w_pp, *ln_f;
    float* out; unsigned char* ws;
    unsigned* ctl; float *rstd1, *rstd2, *rope, *sum, *topw; bf16* WrT; bf16* WgT; int* ident; unsigned* lau; float* rx; unsigned* topd; int* rowtok;
    unsigned char *W13F8, *H1F8, *W2F8, *ACT8, *H2F8; bf16 *H3B, *WoutT, *WpgT, *WppT, *WinT, *W2T, *W13T, *XB, *MIX, *ZA, *H1B, *Q, *K, *V, *O, *ACT, *H2B, *PB, *Gt; unsigned char* YB;
};

__device__ __forceinline__ unsigned cvtpk(float lo, float hi) { unsigned r; asm volatile("v_cvt_pk_bf16_f32 %0, %1, %2" : "=v"(r) : "v"(lo), "v"(hi)); return r; }
__device__ __forceinline__ void p0_item(const float* W, int K, int N, const float* gain, bf16* WT, int rowmode, int sel, float* scr, int item, int lane) {
    const int nblk = N / 64, kb = item / nblk, nb = item % nblk, k0 = 64 * kb, n0 = 64 * nb;
    const float* wp = W + (size_t)k0 * N + n0 + lane;
    { float v[64];
#pragma unroll
        for (int i = 0; i < 64; ++i) v[i] = wp[(size_t)i * N];
#pragma unroll
        for (int i = 0; i < 64; ++i) scr[i * 64 + (lane ^ i)] = v[i] * (gain ? gain[k0 + i] : 1.f); }
    LDS_WAIT();
    const int c = lane & 7, nl = lane >> 3;
#pragma unroll
    for (int jj = 0; jj < 8; ++jj) { const int n = nl + 8 * jj; const int nn = n0 + n; const int row = rowmode ? ((nn >> 7) * 256 + sel * 128 + (nn & 127)) : nn;
        float f[8];
#pragma unroll
        for (int j = 0; j < 8; ++j) { const int kk = 8 * c + j; f[j] = scr[kk * 64 + (n ^ kk)]; }
        u32x4 o; o.x = cvtpk(f[0], f[1]); o.y = cvtpk(f[2], f[3]); o.z = cvtpk(f[4], f[5]); o.w = cvtpk(f[6], f[7]);
        *(u32x4*)(WT + (size_t)row * K + k0 + 8 * c) = o; }
    LDS_WAIT();
}
__device__ __forceinline__ void p0_item_f8(const float* W, int K, int N, const float* gain, float scale, unsigned char* WT8, int rowmode, int sel, float* scr, int item, int lane) {
    asm volatile("" : "+v"(lane));
    const int nblk = N / 64, kb = item / nblk, nb = item % nblk, k0 = 64 * kb, n0 = 64 * nb;
    const float* wp = W + (size_t)k0 * N + n0 + lane;
    { float v[64];
#pragma unroll
        for (int i = 0; i < 64; ++i) v[i] = wp[(size_t)i * N];
#pragma unroll
        for (int i = 0; i < 64; ++i) scr[i * 64 + (lane ^ i)] = v[i] * (gain ? gain[k0 + i] : 1.f) * scale; }
    LDS_WAIT();
    const int c = lane & 3, nl = lane >> 2;
#pragma unroll 1
    for (int jj = 0; jj < 4; ++jj) { const int n = nl + 16 * jj; const int nn = n0 + n; const int row = rowmode ? ((nn >> 7) * 256 + sel * 128 + (nn & 127)) : nn;
        float f[16];
#pragma unroll
        for (int j = 0; j < 16; ++j) { const int kk = 16 * c + j; f[j] = scr[kk * 64 + (n ^ kk)]; }
        u32x4 o;
#pragma unroll
        for (int d = 0; d < 4; ++d) { int w = __builtin_amdgcn_cvt_pk_fp8_f32(f[4 * d], f[4 * d + 1], 0, false); w = __builtin_amdgcn_cvt_pk_fp8_f32(f[4 * d + 2], f[4 * d + 3], w, true); o[d] = (unsigned)w; }
        *(u32x4*)(WT8 + (size_t)row * K + k0 + 16 * c) = o; }
    LDS_WAIT();
}
__device__ __forceinline__ void phase_prologue(Ctx& F) {
    float* scr = (float*)(F.lds + F.wave * 16384);
    const int gw = F.bid * NWAVES + F.wave, NGW = F.G * NWAVES;
    constexpr int I_IN = 16 * 40, I_SQ = 16 * 16, I_PP = 4 * 16, I_E = 64;
    constexpr int N0 = I_IN, N1 = N0 + I_SQ, N2 = N1 + I_SQ, N3 = N2 + I_PP, N4 = N3 + 64 * I_E, N5 = N4 + 64 * I_E, N6 = N5 + I_E, N7 = N6 + I_E, N8 = N7 + 64 * I_E, N9 = N8 + I_E, N10 = N9 + 16, N11 = N10 + 16;
    for (int it = gw; it < N11; it += NGW) {
        const float* W; const float* gain = nullptr; bf16* WT; int K = D, N = D, rowmode = 0, sel = 0, item = it; bool f8 = false;
        if (it < N0) { W = F.w_in; N = DIN; gain = F.ln_mix; WT = F.WinT; }
        else if (it < N1) { W = F.w_out; WT = F.WoutT; item = it - N0; }
        else if (it < N2) { W = F.w_pg; gain = F.ln_ple; WT = F.WpgT; item = it - N1; f8 = true; }
        else if (it < N3) { W = F.w_pp; K = DPLE; WT = F.WppT; item = it - N2; }
        else if (it < N4) { const int r = it - N3, e = r / I_E; W = F.w1 + (size_t)e * D * FE; N = FE; gain = F.ln_moe; WT = (bf16*)(F.W13F8 + (size_t)e * 512 * D); rowmode = 1; item = r % I_E; }
        else if (it < N5) { const int r = it - N4, e = r / I_E; W = F.w3 + (size_t)e * D * FE; N = FE; gain = F.ln_moe; WT = (bf16*)(F.W13F8 + (size_t)e * 512 * D); rowmode = 1; sel = 1; item = r % I_E; }
        else if (it < N6) { W = F.ws1; N = FE; gain = F.ln_moe; WT = (bf16*)(F.W13F8 + (size_t)NE * 512 * D); rowmode = 1; item = it - N5; }
        else if (it < N7) { W = F.ws3; N = FE; gain = F.ln_moe; WT = (bf16*)(F.W13F8 + (size_t)NE * 512 * D); rowmode = 1; sel = 1; item = it - N6; }
        else if (it < N9) { if (F.G == 256) continue;
            if (it < N8) { const int r = it - N7, e = r / I_E; W = F.w2 + (size_t)e * FE * D; K = FE; WT = (bf16*)(F.W2F8 + (size_t)e * D * FE); item = r % I_E; }
            else { W = F.ws2; K = FE; WT = (bf16*)(F.W2F8 + (size_t)NE * D * FE); item = it - N8; }
            p0_item_f8(W, K, N, nullptr, W2SCALE, (unsigned char*)WT, 0, 0, scr, item, F.lane); continue; }
        else if (it < N10) { W = F.w_router; N = NE; gain = F.ln_moe; WT = F.WrT; item = it - N9; }
        else { const int r = it - N10, m = r >> 3, g = r & 7; W = (m ? F.w_i : F.w_a) + (size_t)g * 4096; K = 64; N = 64; WT = F.WgT + (size_t)(m * 8 + g) * 4096; item = 0; }
        if (rowmode || f8) p0_item_f8(W, K, N, gain, rowmode ? W13SCALE : WPGSCALE, (unsigned char*)WT, rowmode, sel, scr, item, F.lane);
        else p0_item(W, K, N, gain, WT, rowmode, sel, scr, item, F.lane);
    }
    { typedef float f32x4_t __attribute__((ext_vector_type(4))); typedef unsigned u32x2_t __attribute__((ext_vector_type(2)));
      for (int rb = gw * 4; rb < T; rb += NGW * 4) {
        f32x4_t v[4][4];
#pragma unroll
        for (int r = 0; r < 4; ++r) { const f32x4_t* xr = (const f32x4_t*)(F.x + (size_t)(rb + r) * D) + F.lane;
#pragma unroll
            for (int j = 0; j < 4; ++j) v[r][j] = xr[64 * j]; }
#pragma unroll
        for (int r = 0; r < 4; ++r) { float s = 0.f;
#pragma unroll
            for (int j = 0; j < 4; ++j) s += v[r][j][0] * v[r][j][0] + v[r][j][1] * v[r][j][1] + v[r][j][2] * v[r][j][2] + v[r][j][3] * v[r][j][3];
            const float rstd = rsqrtf(wave_sum(s) * (1.f / D) + EPS); if (F.lane == 0) F.rx[rb + r] = 1.f / rstd;
            u32x2_t* o = (u32x2_t*)(F.XB + (size_t)(rb + r) * D) + F.lane;
#pragma unroll
            for (int j = 0; j < 4; ++j) o[64 * j] = (u32x2_t){cvtpk(v[r][j][0] * rstd, v[r][j][1] * rstd), cvtpk(v[r][j][2] * rstd, v[r][j][3] * rstd)}; }
      } }
    for (int i = F.bid * NTHR + F.tid; i < T; i += F.G * NTHR) F.ident[i] = i;
    for (int i = F.bid * NTHR + F.tid; i < T * 8; i += F.G * NTHR) {
        const int t = i >> 3, f = i & 7; const float inv = powf(500000.f, -(float)f / 8.f); const float ang = (float)F.positions[t] * inv;
        F.rope[t * 16 + f] = cosf(ang); F.rope[t * 16 + 8 + f] = sinf(ang);
    }
}

__device__ __forceinline__ void phase_gemm1(Ctx& F) {
    pg8::Gemm g{F.XB, F.WinT, T, DIN, D}; pg8::StaticOrder S; S.init(T, DIN, F.G, F.bid);
    pg8::EpiG1 E{F.ZA, F.Q, F.K, F.V, F.rope};
    pg8::gemm_phase<pg8::EpiG1, pg8::StaticOrder, true, true>((LAS unsigned char*)F.lds, g, S, E);
    if (F.G == 256 && F.bid >= 128) {
        float* scr = (float*)(F.lds + F.wave * 16384);
        const int w = (F.bid - 128) * NWAVES + F.wave;
        for (int it = w; it < 65 * 64; it += 128 * NWAVES) { const int e = it >> 6;
            p0_item_f8(e < NE ? F.w2 + (size_t)e * FE * D : F.ws2, FE, D, nullptr, W2SCALE, F.W2F8 + (size_t)e * D * FE, 0, 0, scr, it & 63, F.lane); }
    }
}
constexpr int LDS_SX = 132096, LDS_SPART = 134144;
typedef short rb8 __attribute__((ext_vector_type(8))); typedef float rf4 __attribute__((ext_vector_type(4)));
__device__ __forceinline__ void rglru_pass0_mfma(Ctx& F, int unit, unsigned char* lds) {
    typedef float f32x4_t __attribute__((ext_vector_type(4)));
    const int b = unit / NCHUNK, c = unit % NCHUNK, g = F.wave, l = F.lane, tl = l & 15, q = l >> 4;
    LAS float* xct = (LAS float*)(lds + F.wave * 8192);
    LAS unsigned* lt = (LAS unsigned*)(lds + F.wave * 8192 + 4096);
    const size_t row0 = (size_t)b * SEQ + (size_t)c * CHUNK;
    rb8 Ba[4][2], Bi[4][2];
#pragma unroll
    for (int nt = 0; nt < 4; ++nt)
#pragma unroll
        for (int ks = 0; ks < 2; ++ks) { const size_t o = (size_t)(nt * 16 + tl) * 64 + ks * 32 + q * 8;
            Ba[nt][ks] = *(const rb8*)(F.WgT + (size_t)g * 4096 + o); Bi[nt][ks] = *(const rb8*)(F.WgT + (size_t)(8 + g) * 4096 + o); }
    float cba[4], cbi[4], csp[4];
#pragma unroll
    for (int nt = 0; nt < 4; ++nt) { const int chn = g * 64 + nt * 16 + tl; cba[nt] = F.b_a[chn]; cbi[nt] = F.b_i[chn]; csp[nt] = -8.f * log1pf(expf(-F.rg_lambda[chn])); }
    const int ch = g * 64 + l;
    float h = 0.f, ap = 1.f;
    for (int mt = 0; mt < 4; ++mt) {
        rb8 A[2];
        const int t = mt * 16 + tl;
#pragma unroll
        for (int ks = 0; ks < 2; ++ks) { const int c0 = g * 64 + ks * 32 + q * 8;
            f32x4_t x0 = *(const f32x4_t*)(F.conv_b + c0), x1 = *(const f32x4_t*)(F.conv_b + c0 + 4);
#pragma unroll
            for (int k = 0; k < 4; ++k) { const f32x4_t w0 = *(const f32x4_t*)(F.conv_w + k * 512 + c0), w1 = *(const f32x4_t*)(F.conv_w + k * 512 + c0 + 4);
                u32x4 xv = (u32x4){0u, 0u, 0u, 0u}; if (c > 0 || t + k >= 3) xv = *(const u32x4*)(F.ZA + (size_t)((long)row0 + t + k - 3) * 1024 + c0);
                x0[0] += w0[0] * __uint_as_float(xv.x << 16); x0[1] += w0[1] * __uint_as_float(xv.x & 0xffff0000u); x0[2] += w0[2] * __uint_as_float(xv.y << 16); x0[3] += w0[3] * __uint_as_float(xv.y & 0xffff0000u);
                x1[0] += w1[0] * __uint_as_float(xv.z << 16); x1[1] += w1[1] * __uint_as_float(xv.z & 0xffff0000u); x1[2] += w1[2] * __uint_as_float(xv.w << 16); x1[3] += w1[3] * __uint_as_float(xv.w & 0xffff0000u); }
            u32x4 pkd; pkd.x = cvtpk(x0[0], x0[1]); pkd.y = cvtpk(x0[2], x0[3]); pkd.z = cvtpk(x1[0], x1[1]); pkd.w = cvtpk(x1[2], x1[3]);
            A[ks] = __builtin_bit_cast(rb8, pkd);
            *(LAS f32x4_t*)(xct + tl * 64 + ks * 32 + q * 8) = x0; *(LAS f32x4_t*)(xct + tl * 64 + ks * 32 + q * 8 + 4) = x1; }
        LDS_WAIT();
#pragma unroll
        for (int nt = 0; nt < 4; ++nt) {
            rf4 ca = {0.f, 0.f, 0.f, 0.f}, ci = ca;
            ca = __builtin_amdgcn_mfma_f32_16x16x32_bf16(A[0], Ba[nt][0], ca, 0, 0, 0); ca = __builtin_amdgcn_mfma_f32_16x16x32_bf16(A[1], Ba[nt][1], ca, 0, 0, 0);
            ci = __builtin_amdgcn_mfma_f32_16x16x32_bf16(A[0], Bi[nt][0], ci, 0, 0, 0); ci = __builtin_amdgcn_mfma_f32_16x16x32_bf16(A[1], Bi[nt][1], ci, 0, 0, 0);
#pragma unroll
            for (int r = 0; r < 4; ++r) { const float rr = sigmoidf_(ca[r] + cba[nt]), ig = sigmoidf_(ci[r] + cbi[nt]);
                const float log_a = rr * csp[nt]; const float a = __expf(log_a); const float mult = __builtin_amdgcn_sqrtf(fmaxf(fmaf(-a, a, 1.f), 0.f));
                const float xc = xct[(4 * q + r) * 64 + nt * 16 + tl];
                lt[(4 * q + r) * 64 + nt * 16 + tl] = pk2(log_a, mult * ig * xc); }
        }
        LDS_WAIT();
#pragma unroll
        for (int tt = 0; tt < 16; ++tt) { const unsigned pk = lt[tt * 64 + l];
            F.lau[(row0 + mt * 16 + tt) * 512 + ch] = pk;
            const float ar = __expf(__uint_as_float(pk << 16)), ur = __uint_as_float(pk & 0xffff0000u);
            h = ar * h + ur; ap *= ar; }
        LDS_WAIT();
    }
    float* o = F.sum + ((size_t)(b * NCHUNK + c) * 512 + ch) * 2; o[0] = ap; o[1] = h;
}
__device__ __forceinline__ void rglru_pass1(Ctx& F, int unit) {
    const int b = unit / NCHUNK, c = unit % NCHUNK, g = F.wave, j = F.lane, ch = g * 64 + j;
    float* spart = (float*)(F.lds + LDS_SPART);
    float* ybuf = (float*)(F.lds + F.wave * 16384);
    const size_t row0 = (size_t)b * SEQ + (size_t)c * CHUNK;
    float h = 0.f;
    {
        typedef float f32x2_t __attribute__((ext_vector_type(2)));
        const f32x2_t* sp2 = (const f32x2_t*)F.sum + (size_t)(b * NCHUNK) * 512 + ch;
        { f32x2_t sv[NCHUNK - 1];
#pragma unroll
            for (int i = 0; i < NCHUNK - 1; ++i) sv[i] = (i < c) ? sp2[(size_t)i * 512] : (f32x2_t){1.f, 0.f};
#pragma unroll
            for (int i = 0; i < NCHUNK - 1; ++i) h = sv[i][0] * h + sv[i][1]; }
    }
    for (int t0 = 0; t0 < CHUNK; t0 += 16) { unsigned pk[16]; bf16 gt[16];
#pragma unroll
        for (int i = 0; i < 16; ++i) { pk[i] = F.lau[(row0 + t0 + i) * 512 + ch]; gt[i] = F.ZA[(row0 + t0 + i) * 1024 + 512 + ch]; }
#pragma unroll
        for (int i = 0; i < 16; ++i) { h = __expf(__uint_as_float(pk[i] << 16)) * h + __uint_as_float(pk[i] & 0xffff0000u);
            ybuf[(t0 + i) * 64 + (j ^ (t0 + i))] = h * gelu_tanh(bf2f(gt[i])); } }
    LDS_WAIT();
    { float s = 0.f;
#pragma unroll 16
        for (int cc = 0; cc < 64; ++cc) { const float v = ybuf[j * 64 + (cc ^ j)]; s += v * v; }
        spart[j * 8 + g] = s; }
    __syncthreads();
    const float gr = F.g_rec[ch];
    for (int t = 0; t < CHUNK; ++t) { float s = 0.f;
#pragma unroll
        for (int q = 0; q < 8; ++q) s += spart[t * 8 + q];
        F.MIX[(row0 + t) * 1024 + ch] = f2bf(ybuf[t * 64 + (j ^ t)] * rsqrtf(s * (1.f / 512.f) + EPS) * gr); }
    __syncthreads();
}

__device__ __forceinline__ void attmix_row(Ctx& F, int row) {
    const int lane = F.lane;
    const float s1 = wave_sum(F.lq1[lane] * F.lk1[lane]), s2 = wave_sum(F.lq2[lane] * F.lk2[lane]);
    const float lam = expf(s1) - expf(s2) + LAM_INIT;
    const bf16* op = F.O + (size_t)row * 1024;
    const int h = lane >> 4, e0 = (lane & 15) * 8, vhalf = e0 >> 6, d0 = e0 & 63;
    pg8::f32x4 a0, a1, b0, b1; pg8::unpack8(*(const u32x4*)(op + (h * 4 + 0 + vhalf) * 64 + d0), a0, a1); pg8::unpack8(*(const u32x4*)(op + (h * 4 + 2 + vhalf) * 64 + d0), b0, b1);
    pg8::f32x4 y0 = a0 - b0 * lam, y1 = a1 - b1 * lam;
    float s = (y0[0] * y0[0] + y0[1] * y0[1]) + (y0[2] * y0[2] + y0[3] * y0[3]) + (y1[0] * y1[0] + y1[1] * y1[1]) + (y1[2] * y1[2] + y1[3] * y1[3]);
    s += __shfl_xor(s, 1); s += __shfl_xor(s, 2); s += __shfl_xor(s, 4); s += __shfl_xor(s, 8);
    const float sc = rsqrtf(s * (1.f / 128.f) + EPS) * (1.f - LAM_INIT);
    const pg8::f32x4 g0 = *(const pg8::f32x4*)(F.g_sub + e0), g1 = *(const pg8::f32x4*)(F.g_sub + e0 + 4);
    *(u32x4*)(F.MIX + (size_t)row * 1024 + 512 + h * 128 + e0) = pg8::pack8(y0 * sc * g0, y1 * sc * g1);
}

__device__ __forceinline__ void phase_wout(Ctx& F) {
    pg8::Gemm g{F.MIX, F.WoutT, T, D, D}; pg8::EpiOutF E{F.XB, F.rx, F.H1B};
    if (F.G == 256) { pg8::PanelOrder S{F.vcu}; pg8::gemm_phase<pg8::EpiOutF, pg8::PanelOrder, true, true>((LAS unsigned char*)F.lds, g, S, E); }
    else { pg8::StaticOrder S; S.init(T, D, F.G, F.bid); pg8::gemm_phase<pg8::EpiOutF, pg8::StaticOrder, true, true>((LAS unsigned char*)F.lds, g, S, E); }
}

__device__ __forceinline__ float bcast_lane(float v, int l) { return __uint_as_float(__builtin_amdgcn_readlane(__float_as_uint(v), l)); }
template <bool DRY>
__device__ __forceinline__ void router_block(Ctx& F, int tb, unsigned char* lds) {
    unsigned* cntp = DRY ? F.ctl + 2048 : F.ctl; int* rtk = DRY ? (int*)F.PB : F.rowtok; float* tw = DRY ? (float*)((unsigned char*)F.PB + 4 * MiB) : F.topw; unsigned* td = DRY ? (unsigned*)((unsigned char*)F.PB + 5 * MiB) : F.topd;
    LAS float* lg = (LAS float*)lds;
    LAS float* rsl = (LAS float*)(lds + LDS_SX);
    LAS unsigned* lcnt = (LAS unsigned*)(lds + LDS_SPART);
    const int e = F.lane;
    __syncthreads();
    if (F.tid < 64) lcnt[F.tid] = 0u;
    {
        const int r = e & 15, q = e >> 4, w = F.wave;
        const bf16* ap = F.H1B + (size_t)(tb * 64 + r) * D + w * 128 + q * 8; const bf16* bp = F.WrT + (size_t)r * D + w * 128 + q * 8;
        rf4 c[4][4]; float ss[4];
#pragma unroll
        for (int mt = 0; mt < 4; ++mt) { ss[mt] = 0.f;
#pragma unroll
            for (int nt = 0; nt < 4; ++nt) c[mt][nt] = (rf4){0.f, 0.f, 0.f, 0.f}; }
        u32x4 au[4][4]; rb8 bb[4][4];
#pragma unroll
        for (int ks = 0; ks < 4; ++ks)
#pragma unroll
            for (int i = 0; i < 4; ++i) { au[ks][i] = *(const u32x4*)(ap + (size_t)i * 16 * D + ks * 32); bb[ks][i] = *(const rb8*)(bp + (size_t)i * 16 * D + ks * 32); }
#pragma unroll
        for (int ks = 0; ks < 4; ++ks)
#pragma unroll
            for (int mt = 0; mt < 4; ++mt) { const u32x4 av = au[ks][mt]; const rb8 a = __builtin_bit_cast(rb8, av);
#pragma unroll
                for (int i = 0; i < 4; ++i) { const float lo = __uint_as_float(av[i] << 16), hi = __uint_as_float(av[i] & 0xffff0000u); ss[mt] += lo * lo + hi * hi; }
#pragma unroll
                for (int nt = 0; nt < 4; ++nt) c[mt][nt] = __builtin_amdgcn_mfma_f32_16x16x32_bf16(a, bb[ks][nt], c[mt][nt], 0, 0, 0); }
#pragma unroll
        for (int mt = 0; mt < 4; ++mt) { float sq = ss[mt]; sq += __shfl_xor(sq, 16); sq += __shfl_xor(sq, 32); if (q == 0) rsl[w * 64 + mt * 16 + r] = sq;
#pragma unroll
            for (int j = 0; j < 4; ++j) { LAS float* row = lg + w * 4096 + (mt * 16 + 4 * q + j) * 64 + r;
#pragma unroll
                for (int nt = 0; nt < 4; ++nt) row[nt * 16] = c[mt][nt][j]; } }
    }
    __syncthreads();
    const int t0 = tb * 64 + F.wave * 8;
    float acc[8], rstd[8];
#pragma unroll
    for (int t = 0; t < 8; ++t) { const int tl = F.wave * 8 + t; float a = 0.f, sq = 0.f;
#pragma unroll
        for (int w = 0; w < 8; ++w) { a += lg[w * 4096 + tl * 64 + e]; sq += rsl[w * 64 + tl]; }
        acc[t] = a; rstd[t] = rsqrtf(sq * (1.f / D) + EPS); }
    if (e < 8) { float rv = rstd[0];
#pragma unroll
        for (int t = 1; t < 8; ++t) rv = (e == t) ? rstd[t] : rv;
        F.rstd1[t0 + e] = rv; }
    const float bias = F.e_bias[e];
    bool selb[8]; float wt[8]; int slot[8]; int cntsel = 0;
#pragma unroll
    for (int t = 0; t < 8; ++t) {
        const float sc = __builtin_amdgcn_rcpf(1.f + __expf(-acc[t] * rstd[t])); const float sel = sc + bias;
#define G8F(v) __uint_as_float((unsigned)__builtin_amdgcn_mov_dpp((int)__float_as_uint(v), 0xB1, 0xF, 0xF, false))
#define G8G(v) __uint_as_float((unsigned)__builtin_amdgcn_mov_dpp((int)__float_as_uint(v), 0x4E, 0xF, 0xF, false))
#define G8H(v) __uint_as_float((unsigned)__builtin_amdgcn_mov_dpp((int)__float_as_uint(v), 0x141, 0xF, 0xF, false))
        float m1 = sel; m1 = fmaxf(m1, G8F(m1)); m1 = fmaxf(m1, G8G(m1)); m1 = fmaxf(m1, G8H(m1));
        int fl = (sel == m1) ? e : 64; fl = min(fl, __builtin_amdgcn_mov_dpp(fl, 0xB1, 0xF, 0xF, false)); fl = min(fl, __builtin_amdgcn_mov_dpp(fl, 0x4E, 0xF, 0xF, false)); fl = min(fl, __builtin_amdgcn_mov_dpp(fl, 0x141, 0xF, 0xF, false));
        float m2 = (e == fl) ? -INFINITY : sel; m2 = fmaxf(m2, G8F(m2)); m2 = fmaxf(m2, G8G(m2)); m2 = fmaxf(m2, G8H(m2));
#undef G8F
#undef G8G
#undef G8H
        const float gs = m1 + m2; const int g = e >> 3;
        int grank = 0;
#pragma unroll
        for (int gg = 0; gg < 8; ++gg) { const float o = bcast_lane(gs, gg * 8); grank += (o > gs || (o == gs && gg < g)) ? 1 : 0; }
        const bool elig = grank < 4; const float ms = elig ? sel : -INFINITY;
        int rank = 0;
        for (unsigned long long em = __ballot(elig); em != 0ull; em &= em - 1ull) { const int j = __builtin_ctzll(em); const float o = bcast_lane(ms, j); rank += (o > ms || (o == ms && j < e)) ? 1 : 0; }
        const bool sl = elig && rank < 8;
        float wsum = 0.f; for (unsigned long long sm = __ballot(sl); sm != 0ull; sm &= sm - 1ull) wsum += bcast_lane(sc, __builtin_ctzll(sm));
        selb[t] = sl; wt[t] = sc / wsum * 2.5f; slot[t] = rank; cntsel += sl ? 1 : 0;
    }
    unsigned wofs = 0u; if (cntsel > 0) wofs = __hip_atomic_fetch_add(lcnt + e, (unsigned)cntsel, __ATOMIC_RELAXED, __HIP_MEMORY_SCOPE_WORKGROUP);
    __syncthreads();
    if (F.wave == 0) { const unsigned c = lcnt[e]; unsigned gb = 0u; if (c > 0u) gb = atomicAdd(&cntp[e], c); lcnt[64 + e] = gb; }
    __syncthreads();
    unsigned base = lcnt[64 + e] + wofs;
#pragma unroll
    for (int t = 0; t < 8; ++t) if (selb[t]) { const unsigned pos = base++; const int tok = t0 + t; rtk[e * ECAP + pos] = tok; tw[tok * 8 + slot[t]] = wt[t]; td[tok * 8 + slot[t]] = ((unsigned)e << 16) | pos; }
    if (!DRY) {
        u32x4 hv[8][2];
#pragma unroll
        for (int t = 0; t < 8; ++t) { const u32x4* hp = (const u32x4*)(F.H1B + (size_t)(t0 + t) * D) + e * 2; hv[t][0] = hp[0]; hv[t][1] = hp[1]; }
#pragma unroll
        for (int t = 0; t < 8; ++t) { const float sc8 = rstd[t] * H1SCALE; u32x4 o;
#pragma unroll
            for (int h = 0; h < 2; ++h)
#pragma unroll
                for (int d = 0; d < 2; ++d) { const unsigned w0 = hv[t][h][2 * d], w1 = hv[t][h][2 * d + 1];
                    int pk = __builtin_amdgcn_cvt_pk_fp8_f32(__uint_as_float(w0 << 16) * sc8, __uint_as_float(w0 & 0xffff0000u) * sc8, 0, false);
                    pk = __builtin_amdgcn_cvt_pk_fp8_f32(__uint_as_float(w1 << 16) * sc8, __uint_as_float(w1 & 0xffff0000u) * sc8, pk, true); o[2 * h + d] = (unsigned)pk; }
            *(u32x4*)(F.H1F8 + (size_t)(t0 + t) * D + e * 16) = o; }
    }
}

__device__ __forceinline__ const unsigned* expert_offsets(Ctx& F) {
    unsigned* so = (unsigned*)(F.lds + 100 * 1024);
    __syncthreads();
    if (F.tid < 64) { const unsigned c = __hip_atomic_load(&F.ctl[F.tid], __ATOMIC_RELAXED, __HIP_MEMORY_SCOPE_AGENT); unsigned o = c;
#pragma unroll
        for (int d = 1; d < 64; d <<= 1) { const unsigned yo = __shfl_up(o, d); if (F.tid >= d) o += yo; }
        so[128 + F.tid] = c; so[F.tid] = o - c; if (F.tid == NE - 1) so[NE] = o; }
    __syncthreads();
    return so;
}

constexpr int LDS_MOETAB = 136192;
__device__ __forceinline__ const LAS unsigned* moe_table(Ctx& F, unsigned char* lds) {
    LAS unsigned* tab = (LAS unsigned*)(lds + LDS_MOETAB);
    __syncthreads();
    if (F.tid < NE) {
        const unsigned c = __hip_atomic_load(&F.ctl[F.tid], __ATOMIC_RELAXED, __HIP_MEMORY_SCOPE_AGENT), tl = (c + 255u) >> 8; unsigned o = c, p = tl;
#pragma unroll
        for (int d = 1; d < 64; d <<= 1) { const unsigned yo = __shfl_up(o, d), yp = __shfl_up(p, d); if (F.tid >= d) { o += yo; p += yp; } }
        tab[128 + F.tid] = c; tab[F.tid] = o - c; tab[256 + F.tid] = p - tl;
        if (F.tid == NE - 1) { tab[128 + NE] = (unsigned)T; tab[NE] = 131072u; tab[256 + NE] = p; tab[256 + NE + 1] = p + T / 256; } }
    __syncthreads();
    return tab;
}
__device__ __forceinline__ void phase_moe_up(Ctx& F, unsigned char* lds) {
    const LAS unsigned* tab = moe_table(F, lds);
    const int vcu = (F.G % 8 == 0) ? (F.bid % 8) * (F.G / 8) + F.bid / 8 : F.bid;
    pg8::MoeOrder S{tab, 2, vcu, F.G, F.rowtok, (const bf16*)F.W13F8, (size_t)512 * 512, 512, true, PROBE_PHASE == 7 ? 2 : 1, F.ident, (const int*)(F.ctl + 3000)};
    { LAS unsigned* tw = (LAS unsigned*)(lds + LDS_MOETAB); if (F.tid < 64) tw[384 + F.tid] = S.unit_at(F.tid); __syncthreads(); }
    pg8::EpiUpG E{F.ACT8, tab, 1.f / (W13SCALE * H1SCALE), ASCALE};
    pg8::gemm_phase_g<pg8::EpiUpG, pg8::MoeOrder, true, true, true>((LAS unsigned char*)lds, (const bf16*)F.H1F8, 512, S, E);
}
__device__ __forceinline__ void phase_moe_down(Ctx& F, unsigned char* lds) {
    { typedef float f32x4_t __attribute__((ext_vector_type(4))); typedef unsigned u32x2_t __attribute__((ext_vector_type(2)));
      for (int i = F.bid * NTHR + F.tid; i < T * DPLE / 4; i += F.G * NTHR) { const f32x4_t v = ((const f32x4_t*)F.p)[i]; ((u32x2_t*)F.PB)[i] = (u32x2_t){pk2(v[0], v[1]), pk2(v[2], v[3])}; } }
    const LAS unsigned* tab = moe_table(F, lds);
    const int vcu = (F.G % 8 == 0) ? (F.bid % 8) * (F.G / 8) + F.bid / 8 : F.bid;
    pg8::MoeOrder S{tab, 4, vcu, F.G, nullptr, (const bf16*)F.W2F8, (size_t)1024 * 128, 128, false, PROBE_PHASE == 8 ? 2 : 1, nullptr, nullptr};
    { LAS unsigned* tw = (LAS unsigned*)(lds + LDS_MOETAB); if (F.tid < 64) tw[384 + F.tid] = S.unit_at(F.tid); __syncthreads(); }
    pg8::EpiDownG E{F.YB, F.out, tab, YSCALE / (ASCALE * W2SCALE)};
    pg8::gemm_phase_g<pg8::EpiDownG, pg8::MoeOrder, false, false, true>((LAS unsigned char*)lds, (const bf16*)F.ACT8, 128, S, E);
}
template <bool DRY>
__device__ __forceinline__ void phase_combine(Ctx& F, unsigned char* lds) {
    const unsigned* so = expert_offsets(F);
    const int gw = (F.G == 256 ? F.vcu : F.bid) * NWAVES + F.wave, NGW = F.G * NWAVES;
    typedef float f32x4_t __attribute__((ext_vector_type(4))); typedef float f32x2_t __attribute__((ext_vector_type(2)));
    for (int t8 = gw * 8; t8 < T; t8 += NGW * 8) {
        typedef unsigned u32x2_t __attribute__((ext_vector_type(2)));
        const unsigned dd = F.topd[t8 * 8 + F.lane]; const float wl = F.topw[t8 * 8 + F.lane] * (1.f / YSCALE); const unsigned rowl = so[dd >> 16] + (dd & 0xffffu);
#pragma unroll 2
        for (int tt = 0; tt < 8; ++tt) { const int t = t8 + tt;
            pg8::f32x4 h[4];
            u32x2_t y0[9], y1[9]; float w[9];
#pragma unroll
            for (int k = 0; k < 9; ++k) { size_t row;
                if (k < 8) { row = (size_t)(unsigned)__builtin_amdgcn_readlane((int)rowl, tt * 8 + k); w[k] = bcast_lane(wl, tt * 8 + k); } else { row = (size_t)131072 + t; w[k] = 1.f / YSCALE; }
                const u32x2_t* yp = (const u32x2_t*)(F.YB + row * D) + F.lane; y0[k] = yp[0]; y1[k] = yp[64]; }
            { const u32x4* hp = (const u32x4*)(F.H1B + (size_t)t * D) + F.lane; pg8::unpack8(hp[0], h[0], h[1]); pg8::unpack8(hp[64], h[2], h[3]); }
#pragma unroll
            for (int k = 0; k < 9; ++k) { const unsigned yy[4] = {y0[k].x, y0[k].y, y1[k].x, y1[k].y};
#pragma unroll
                for (int q = 0; q < 4; ++q) { const f32x2_t lo = __builtin_amdgcn_cvt_pk_f32_fp8((int)yy[q], false), hi = __builtin_amdgcn_cvt_pk_f32_fp8((int)yy[q], true);
                    h[q][0] += w[k] * lo[0]; h[q][1] += w[k] * lo[1]; h[q][2] += w[k] * hi[0]; h[q][3] += w[k] * hi[1]; } }
            float ssq = 0.f;
#pragma unroll
            for (int q = 0; q < 4; ++q) ssq += h[q][0] * h[q][0] + h[q][1] * h[q][1] + h[q][2] * h[q][2] + h[q][3] * h[q][3];
            u32x4* hb = (u32x4*)(F.H2B + (size_t)t * D) + F.lane; hb[0] = pg8::pack8(h[0], h[1]); hb[64] = pg8::pack8(h[2], h[3]);
            const float rstd = rsqrtf(wave_sum(ssq) * (1.f / D) + EPS);
            { const float s8 = rstd * H2SCALE; u32x2_t o0, o1;
              int pk = __builtin_amdgcn_cvt_pk_fp8_f32(h[0][0] * s8, h[0][1] * s8, 0, false); pk = __builtin_amdgcn_cvt_pk_fp8_f32(h[0][2] * s8, h[0][3] * s8, pk, true); o0.x = (unsigned)pk;
              pk = __builtin_amdgcn_cvt_pk_fp8_f32(h[1][0] * s8, h[1][1] * s8, 0, false); pk = __builtin_amdgcn_cvt_pk_fp8_f32(h[1][2] * s8, h[1][3] * s8, pk, true); o0.y = (unsigned)pk;
              pk = __builtin_amdgcn_cvt_pk_fp8_f32(h[2][0] * s8, h[2][1] * s8, 0, false); pk = __builtin_amdgcn_cvt_pk_fp8_f32(h[2][2] * s8, h[2][3] * s8, pk, true); o1.x = (unsigned)pk;
              pk = __builtin_amdgcn_cvt_pk_fp8_f32(h[3][0] * s8, h[3][1] * s8, 0, false); pk = __builtin_amdgcn_cvt_pk_fp8_f32(h[3][2] * s8, h[3][3] * s8, pk, true); o1.y = (unsigned)pk;
              u32x2_t* h8 = (u32x2_t*)(F.H2F8 + (size_t)t * D) + F.lane; h8[0] = o0; h8[64] = o1; }
            if (F.lane == 0) F.rstd2[t] = rstd; }
    }
    __syncthreads();
    if (!DRY) {
        pg8::Gemm g{F.PB, F.WppT, T, D, DPLE}; pg8::EpiStoreBf16 E{F.Gt};
        if (F.G == 256) { pg8::PanelOrder S{F.vcu}; pg8::gemm_phase<pg8::EpiStoreBf16, pg8::PanelOrder, true, true>((LAS unsigned char*)lds, g, S, E); }
        else { pg8::StaticOrder S; S.init(T, D, F.G, F.bid); pg8::gemm_phase<pg8::EpiStoreBf16, pg8::StaticOrder, true, true>((LAS unsigned char*)lds, g, S, E); }
    }
}
__device__ __forceinline__ void phase_gate(Ctx& F) {
    constexpr float cs = 1.f / (H2SCALE * WPGSCALE);
    pg8::Gemm g{(const bf16*)F.H2F8, F.WpgT, T, D, D / 2}; pg8::EpiGateFused E{F.H3B, F.H2B, F.Gt, cs};
    if (F.G == 256) { pg8::PanelOrder S{F.vcu}; pg8::EpiGateFinal EF{F.out, F.H2B, F.Gt, cs, F.ln_f, (float*)(F.ws + WS_XS), F.ctl};
        pg8::gemm_phase<pg8::EpiGateFinal, pg8::PanelOrder, true, true, true>((LAS unsigned char*)F.lds, g, S, EF); }
    else { pg8::StaticOrder S; S.init(T, D, F.G, F.bid); pg8::gemm_phase<pg8::EpiGateFused, pg8::StaticOrder, true, true, true>((LAS unsigned char*)F.lds, g, S, E); }
}
template <bool DRY>
__device__ __forceinline__ void phase_final(Ctx& F) {
    typedef float f32x4_t __attribute__((ext_vector_type(4))); typedef unsigned u32x2_t __attribute__((ext_vector_type(2)));
    const int gw = (F.G == 256 ? F.vcu : F.bid) * NWAVES + F.wave, NGW = F.G * NWAVES;
    f32x4_t g[4];
#pragma unroll
    for (int q = 0; q < 4; ++q) g[q] = ((const f32x4_t*)F.ln_f)[q * 64 + F.lane];
    for (int r8 = gw * 8; r8 < T; r8 += NGW * 8)
    for (int row = r8; row < r8 + 8; ++row) {
        const u32x2_t* hp = (const u32x2_t*)(F.H3B + (size_t)row * D) + F.lane; f32x4_t h[4]; float s = 0.f;
#pragma unroll
        for (int q = 0; q < 4; ++q) { const u32x2_t w = hp[q * 64]; h[q][0] = __uint_as_float(w.x << 16); h[q][1] = __uint_as_float(w.x & 0xffff0000u); h[q][2] = __uint_as_float(w.y << 16); h[q][3] = __uint_as_float(w.y & 0xffff0000u);
            s += h[q][0] * h[q][0] + h[q][1] * h[q][1] + h[q][2] * h[q][2] + h[q][3] * h[q][3]; }
        const float rstd = rsqrtf(wave_sum(s) * (1.f / D) + EPS);
        f32x4_t* op = (f32x4_t*)(F.out + (size_t)row * D) + F.lane;
#pragma unroll
        for (int q = 0; q < 4; ++q) op[q * 64] = h[q] * rstd * g[q];
    }
}

constexpr int NPHASE = 13;
__global__ void __launch_bounds__(NTHR, 2) mk_fwd(Args args) {
    extern __shared__ __attribute__((aligned(16))) unsigned char lds[];
    Ctx F;
    F.lds = lds; F.tid = threadIdx.x; F.lane = F.tid & 63; F.wave = __builtin_amdgcn_readfirstlane(F.tid >> 6); F.bid = blockIdx.x; F.G = gridDim.x; F.vcu = (F.G % 8 == 0) ? (F.bid % 8) * (F.G / 8) + F.bid / 8 : F.bid;
    const void* const* in = args.in;
    F.x = (const float*)in[0]; F.p = (const float*)in[1]; F.positions = (const int*)in[2]; F.ln_mix = (const float*)in[3]; F.w_in = (const float*)in[4]; F.conv_w = (const float*)in[5]; F.conv_b = (const float*)in[6];
    F.w_a = (const float*)in[7]; F.b_a = (const float*)in[8]; F.w_i = (const float*)in[9]; F.b_i = (const float*)in[10]; F.rg_lambda = (const float*)in[11]; F.g_rec = (const float*)in[12];
    F.lq1 = (const float*)in[13]; F.lk1 = (const float*)in[14]; F.lq2 = (const float*)in[15]; F.lk2 = (const float*)in[16]; F.g_sub = (const float*)in[17]; F.w_out = (const float*)in[18];
    F.ln_moe = (const float*)in[19]; F.w_router = (const float*)in[20]; F.e_bias = (const float*)in[21]; F.w1 = (const float*)in[22]; F.w3 = (const float*)in[23]; F.w2 = (const float*)in[24];
    F.ws1 = (const float*)in[25]; F.ws3 = (const float*)in[26]; F.ws2 = (const float*)in[27]; F.ln_ple = (const float*)in[28]; F.w_pg = (const float*)in[29]; F.w_pp = (const float*)in[30]; F.ln_f = (const float*)in[31];
    F.out = args.out; unsigned char* ws = args.ws; F.ws = ws;
    F.ctl = (unsigned*)(ws + WS_CTL); F.rstd1 = (float*)(ws + WS_RSTD1); F.rstd2 = (float*)(ws + WS_RSTD2); F.rope = (float*)(ws + WS_ROPE); F.WrT = (bf16*)(ws + WS_WR); F.ident = (int*)(ws + WS_IDENT); F.rx = (float*)(ws + WS_RX); F.WgT = (bf16*)(ws + WS_WG); F.lau = (unsigned*)(ws + WS_LAU); F.sum = (float*)(ws + WS_SUM);
    F.topw = (float*)(ws + WS_TOPW); F.topd = (unsigned*)(ws + WS_TOPD); F.rowtok = (int*)(ws + WS_ROWTOK);
    F.WoutT = (bf16*)(ws + WS_WOUT); F.WpgT = (bf16*)(ws + WS_WPG); F.WppT = (bf16*)(ws + WS_WPP); F.WinT = (bf16*)(ws + WS_WIN); F.W2T = (bf16*)(ws + WS_W2); F.W13T = (bf16*)(ws + WS_W13); F.W13F8 = ws + WS_W13; F.W2F8 = ws + WS_W2; F.ACT8 = ws + WS_ACT; F.H2F8 = ws + WS_H2F8; F.H1F8 = (unsigned char*)args.out + 32 * MiB;     F.H3B = (bf16*)(ws + WS_H3B);
    F.XB = (bf16*)(ws + WS_XB); F.MIX = (bf16*)(ws + WS_MIX); F.ZA = (bf16*)(ws + WS_ZA); F.H1B = (bf16*)args.out;     F.Q = (bf16*)(ws + WS_Q); F.K = (bf16*)(ws + WS_K); F.V = (bf16*)(ws + WS_V); F.O = (bf16*)(ws + WS_O);
    F.ACT = (bf16*)(ws + WS_ACT); F.YB = ws + WS_YB; F.H2B = (bf16*)(ws + WS_H2B); F.PB = (bf16*)(ws + WS_PB); F.Gt = (bf16*)(ws + WS_G);

    for (int u = F.tid; u < (LDS_BYTES - LDSCTL_OFF) / 4; u += NTHR) ((unsigned*)(lds + LDSCTL_OFF))[u] = 0u;
    __syncthreads();
    if (F.lane == 0) ((volatile unsigned*)(lds + LDSCTL_OFF))[hw_slot()] = (unsigned)F.wave;
    __syncthreads();
    const bool one_launch = (args.ph_lo == 0 && args.ph_hi == NPHASE);
    XcdBarrier bar; bar.bar = F.ctl + CW_BAR; bar.x = 0; bar.st = nullptr;
    if (args.ph_hi - args.ph_lo > 1) bar = xcd_barrier_post(F.ctl + CW_BAR, (volatile LAS unsigned*)(lds + MISC_OFF + 32));
    (void)one_launch;
    const int lo = args.ph_lo, hi = args.ph_hi;
#define IN(k) (lo <= (k) && (k) < hi)
#define REP(k, body) do { body; if ((k) == PROBE_PHASE) { body; } } while (0)
#define REFRESH() do { F.tid = opaque_tid(); F.lane = F.tid & 63; } while (0)
#define SEAM(k) do { if (IN(k) && IN((k) + 1)) xcd_barrier(bar); } while (0)
#define PSEAM(k, st) do { if (IN(k) && IN((k) + 1)) { if (F.G == 256) panel_barrier(F.ctl, st, F.vcu >> 2); else xcd_barrier(bar); } } while (0)
    const int gw = F.bid * NWAVES + F.wave, NGW = F.G * NWAVES;

    REFRESH(); if (IN(0)) { REP(0, phase_prologue(F); __syncthreads()); } SEAM(0);
    REFRESH(); if (IN(1)) { REP(1, phase_gemm1(F)); } SEAM(1);
      if (IN(2)) {}
#define PH3_BODY() do { for (int unit = F.bid; unit < NBATCH * NCHUNK; unit += F.G) rglru_pass0_mfma(F, unit, lds); \
        __syncthreads(); \
        { const attn_body::AttnTensors AT{(const attn_body::bf16*)F.Q, (const attn_body::bf16*)F.K, (const attn_body::bf16*)F.V, (attn_body::bf16*)F.O}; \
          const attn_body::StaticOrder SA(F.G, F.bid); \
          attn_body::attn_phase<attn_body::StaticOrder>((char*)lds, AT, SA); } } while (0)
#define PH4_BODY() do { const int ub = (F.G == 256) ? F.vcu : F.bid; for (int unit = ub; unit < NBATCH * NCHUNK; unit += F.G) rglru_pass1(F, unit); \
        for (int r8 = (ub * NWAVES + F.wave) * 8; r8 < T; r8 += NGW * 8) for (int row = r8; row < r8 + 8; ++row) attmix_row(F, row); } while (0)
    REFRESH(); if (IN(3)) { REP(3, PH3_BODY()); } SEAM(3);
    REFRESH(); if (IN(4)) { REP(4, PH4_BODY()); } PSEAM(4, 0);
    REFRESH(); if (IN(5)) { REP(5, phase_wout(F)); } PSEAM(5, 1);
    REFRESH(); if (IN(6)) { if (PROBE_PHASE == 6) { for (int tb = (F.G == 256 ? F.vcu : F.bid); tb < T / 64; tb += F.G) router_block<true>(F, tb, lds); } for (int tb = (F.G == 256 ? F.vcu : F.bid); tb < T / 64; tb += F.G) router_block<false>(F, tb, lds); } SEAM(6);
    REFRESH(); if (IN(7)) { phase_moe_up(F, lds); } SEAM(7);
    REFRESH(); if (IN(8)) { phase_moe_down(F, lds); } SEAM(8);
    REFRESH(); if (IN(9)) { if (PROBE_PHASE == 9) phase_combine<true>(F, lds); phase_combine<false>(F, lds); } SEAM(9);
    REFRESH(); if (IN(10)) { REP(10, phase_gate(F)); } if (IN(10) && IN(12) && F.G != 256) xcd_barrier(bar);
    REFRESH(); if (IN(12) && F.G != 256) { REP(12, phase_final<false>(F)); }
#undef IN
#undef SEAM
}

#ifndef MK_N_LAUNCHES
#define MK_N_LAUNCHES 1
#endif
extern "C" void kernel_launch(void* const* d_in, const int* in_sizes, int n_in, void* d_out, int out_size, void* d_ws, size_t ws_size, hipStream_t stream) {
    static int grid = 0;
    if (grid == 0) {
        if (n_in != 32 || ws_size < WS_END || out_size != T * D) { grid = -1; return; }
        int dev = 0, cus = 0;
        if (hipGetDevice(&dev) != hipSuccess || hipDeviceGetAttribute(&cus, hipDeviceAttributeMultiprocessorCount, dev) != hipSuccess) { grid = -1; return; }
        if (hipFuncSetAttribute((const void*)mk_fwd, hipFuncAttributeMaxDynamicSharedMemorySize, LDS_BYTES) != hipSuccess) { grid = -1; return; }
        int per_cu = 0; (void)hipOccupancyMaxActiveBlocksPerMultiprocessor(&per_cu, (const void*)mk_fwd, NTHR, LDS_BYTES); (void)hipGetLastError();
        grid = cus;
    }
    if (grid < 0) return;
    (void)hipMemsetAsync((char*)d_ws + WS_CTL, 0, CTL_ZERO_BYTES, stream);
    Args a{};
    for (int i = 0; i < 32; ++i) a.in[i] = d_in[i];
    a.out = (float*)d_out; a.ws = (unsigned char*)d_ws;
    if (MK_N_LAUNCHES == 1) { a.ph_lo = 0; a.ph_hi = NPHASE; hipLaunchKernelGGL(mk_fwd, dim3(grid), dim3(NTHR), LDS_BYTES, stream, a); }
    else { for (int ph = 0; ph < NPHASE; ++ph) { a.ph_lo = ph; a.ph_hi = ph + 1; hipLaunchKernelGGL(mk_fwd, dim3(grid), dim3(NTHR), LDS_BYTES, stream, a); } }
}
```

```cpp
#include <hip/hip_runtime.h>
#include <hip/hip_bf16.h>
#include <stdint.h>
#include <math.h>

#ifndef PROBE_PHASE
#define PROBE_PHASE -1
#endif
typedef unsigned short bf16;
typedef unsigned u32x4 __attribute__((ext_vector_type(4)));
#define LAS __attribute__((address_space(3)))

constexpr int T = 16384, SEQ = 4096, NBATCH = 4, D = 1024, DIN = 2560, NE = 64, FE = 256, DPLE = 256;
constexpr int ECAP = 16384;
constexpr int NWAVES = 8, NTHR = 512;
constexpr int CHUNK = 64, NCHUNK = SEQ / CHUNK;
constexpr float EPS = 1e-6f;
constexpr float LAM_INIT = 0.2f;
constexpr float YSCALE = 16.f;
constexpr float W2SCALE = 16.f, ASCALE = 8.f;
constexpr float H2SCALE = 8.f, WPGSCALE = 32.f;
constexpr float H1SCALE = 8.f;
constexpr float W13SCALE = 32.f;
constexpr float C2 = 0.125f * 1.4426950408889634f;

constexpr size_t MiB = 1u << 20;
constexpr size_t WS_CTL = 0, CTL_ZERO_BYTES = 128 * 1024;
constexpr int CW_BAR = 4096;
constexpr size_t WS_RSTD1 = 256 * 1024;
constexpr size_t WS_RSTD2 = 320 * 1024;
constexpr size_t WS_WG = 448 * 1024;
constexpr size_t WS_IDENT = 384 * 1024;
constexpr size_t WS_RX = 576 * 1024;
constexpr size_t WS_XS = 640 * 1024;
constexpr size_t WS_ROPE = 1 * MiB;
constexpr size_t WS_SUM = 2 * MiB;
constexpr size_t WS_TOPW = 3 * MiB;
constexpr size_t WS_TOPD = 3 * MiB + 512 * 1024;
constexpr size_t WS_ROWTOK = 4 * MiB;
constexpr size_t WS_WOUT = 8 * MiB;
constexpr size_t WS_WPG = 15 * MiB;
constexpr size_t WS_WPP = 17 * MiB;
constexpr size_t WS_WR = 17 * MiB + 512 * 1024;
constexpr size_t WS_WIN = 10 * MiB;
constexpr size_t WS_W2 = 18 * MiB;
constexpr size_t WS_W13 = 51 * MiB;
constexpr size_t WS_XB = 116 * MiB;
constexpr size_t WS_MIX = 180 * MiB;
constexpr size_t WS_ZA = 148 * MiB;
constexpr size_t WS_H1B = 260 * MiB;
constexpr size_t WS_Q = 180 * MiB, WS_K = 196 * MiB, WS_V = 212 * MiB;
constexpr size_t WS_O = 228 * MiB;
constexpr size_t WS_ACT = 196 * MiB;
constexpr size_t WS_YB = 51 * MiB;
constexpr size_t WS_H2B = 228 * MiB;
constexpr size_t WS_PB = 4 * MiB;
constexpr size_t WS_G = 196 * MiB;
constexpr size_t WS_H2F8 = 260 * MiB;
constexpr size_t WS_H3B = 51 * MiB;
constexpr size_t WS_LAU = 260 * MiB;
constexpr size_t WS_END = 292 * MiB;

constexpr int RING_BYTES = 131072, LDSCTL_OFF = RING_BYTES, MISC_OFF = LDSCTL_OFF + 320, LDS_BYTES = 147456;

__device__ __forceinline__ float bf2f(bf16 v) { return __uint_as_float(((unsigned)v) << 16); }
__device__ __forceinline__ bf16 f2bf(float f) { unsigned u = __float_as_uint(f); return (bf16)((u + 0x7fffu + ((u >> 16) & 1u)) >> 16); }
__device__ __forceinline__ unsigned pk2(float lo, float hi) { return (unsigned)f2bf(lo) | ((unsigned)f2bf(hi) << 16); }
__device__ __forceinline__ unsigned char f2fp8(float v) { int r = __builtin_amdgcn_cvt_pk_fp8_f32(v, v, 0, false); return (unsigned char)(r & 0xff); }
__device__ __forceinline__ float fp82f(unsigned char b) { return __builtin_amdgcn_cvt_f32_fp8((int)b, 0); }
__device__ __forceinline__ float wave_sum(float v) {
#pragma unroll
    for (int o = 1; o < 64; o <<= 1) v += __shfl_xor(v, o);
    return v;
}
__device__ __forceinline__ float sigmoidf_(float x) { return __builtin_amdgcn_rcpf(1.f + __expf(-x)); }
__device__ __forceinline__ float gelu_tanh(float x) { const float y = 1.5957691216057308f * (x + 0.044715f * x * x * x); return x * __builtin_amdgcn_rcpf(1.f + __expf(-y)); }
#define LDS_WAIT() asm volatile("s_waitcnt lgkmcnt(0)" ::: "memory")
__device__ __forceinline__ unsigned hw_slot() { return (unsigned)__builtin_amdgcn_s_getreg((5 << 11) | 4) & 0x3fu; }
__device__ __forceinline__ int opaque_tid() {
    const unsigned w = *(volatile LAS unsigned*)(unsigned)(131072u + 4u * hw_slot());
    int l; asm volatile("v_mbcnt_lo_u32_b32 %0, -1, 0\n\tv_mbcnt_hi_u32_b32 %0, -1, %0" : "=v"(l));
    return (int)(((unsigned)__builtin_amdgcn_readfirstlane((int)w) << 6) | (unsigned)l); }

#define XB_TMO      128
#define XB_XCNT(j)  (256  + 64 * (j))
#define XB_XSUB(j)  (1280 + 64 * (j))
#define XB_XGEN(j)  (2304 + 64 * (j))
#define XB_TOP      3328
#define XB_TOPGEN   3392
#define XCD_BAR_WORDS 3456
#define XB_SPIN_CAP (1u << 20)
__device__ __forceinline__ unsigned xb_ld(unsigned* p)              { return __hip_atomic_load(p, __ATOMIC_RELAXED, __HIP_MEMORY_SCOPE_AGENT); }
__device__ __forceinline__ unsigned xb_add(unsigned* p, unsigned v) { return __hip_atomic_fetch_add(p, v, __ATOMIC_RELAXED, __HIP_MEMORY_SCOPE_AGENT); }
__device__ __forceinline__ unsigned xb_xcc_id() { return (unsigned)__builtin_amdgcn_s_getreg((3 << 11) | 20) & 0xFu; }
#define XB_SPIN(cond, bar) do { unsigned _sp = 0; while (cond) { __builtin_amdgcn_s_sleep(1); \
    if ((++_sp & 255u) == 0u) { if (xb_ld(&(bar)[XB_TMO])) break; if (_sp > XB_SPIN_CAP) { atomicAdd(&(bar)[XB_TMO], 1u); break; } } } } while (0)
struct XcdBarrier { unsigned* bar; unsigned x; volatile LAS unsigned* st; };
__device__ __forceinline__ XcdBarrier xcd_barrier_post(unsigned* bar, volatile LAS unsigned* st) {
    XcdBarrier b; b.bar = bar; b.x = xb_xcc_id(); b.st = st;
    if (opaque_tid() == 0) (void)xb_add(&bar[XB_XCNT(b.x)], 1u);
    return b;
}
__device__ __forceinline__ void xcd_barrier_complete(unsigned* bar, unsigned x, unsigned& nloc, unsigned& nx) {
    const unsigned G = gridDim.x * gridDim.y * gridDim.z;
    unsigned sum, cnt, mine, sp = 0u;
    for (;;) {
        sum = 0u; cnt = 0u; mine = 0u;
#pragma unroll
        for (unsigned j = 0; j < 16; ++j) { const unsigned c = xb_ld(&bar[XB_XCNT(j)]); sum += c; cnt += (c > 0u) ? 1u : 0u; mine = (j == x) ? c : mine; }
        if (sum == G) break;
        __builtin_amdgcn_s_sleep(1);
        if ((++sp & 255u) == 0u) { if (xb_ld(&bar[XB_TMO])) break; if (sp > XB_SPIN_CAP) { atomicAdd(&bar[XB_TMO], 1u); break; } }
    }
    nloc = mine > 0u ? mine : 1u; nx = cnt > 0u ? cnt : 1u;
}
__device__ __forceinline__ void xcd_barrier(const XcdBarrier& b) {
    asm volatile("s_waitcnt vmcnt(0)" ::: "memory");
    __syncthreads();
    if (opaque_tid() == 0) {
        unsigned* bar = b.bar;
        __builtin_amdgcn_s_waitcnt(0);
        unsigned nloc = b.st[0], nx = b.st[1];
        if (nloc == 0u) { xcd_barrier_complete(bar, b.x, nloc, nx); b.st[0] = nloc; b.st[1] = nx; }
        const unsigned old = xb_add(&bar[XB_XSUB(b.x)], 1u);
        const unsigned gen = old / nloc;
        if (old + 1u == (gen + 1u) * nloc) {
            __builtin_amdgcn_fence(__ATOMIC_RELEASE, "agent");
            asm volatile("s_waitcnt vmcnt(0)" ::: "memory");
            const unsigned og = xb_add(&bar[XB_TOP], 1u);
            const unsigned tg = og / nx;
            if (og + 1u == (tg + 1u) * nx) xb_add(&bar[XB_TOPGEN], 1u);
            else XB_SPIN(xb_ld(&bar[XB_TOPGEN]) == tg, bar);
            __builtin_amdgcn_fence(__ATOMIC_ACQUIRE, "agent");
            xb_add(&bar[XB_XGEN(b.x)], 1u);
            asm volatile("s_waitcnt vmcnt(0)" ::: "memory");
        } else {
            XB_SPIN(xb_ld(&bar[XB_XGEN(b.x)]) == gen, bar);
            __builtin_amdgcn_fence(__ATOMIC_ACQUIRE, "agent");
            asm volatile("s_waitcnt vmcnt(0)" ::: "memory");
        }
    }
    __syncthreads();
}

constexpr int NE_P1 = 65, ECAP_ = 16384, IDXBUF = 138240;
namespace pg8 {
#define PG8_LAS __attribute__((address_space(3)))
typedef unsigned short bf16_t;
typedef short bf16x8 __attribute__((ext_vector_type(8)));
typedef float f32x4 __attribute__((ext_vector_type(4)));
typedef unsigned u32x4 __attribute__((ext_vector_type(4)));
constexpr int BM = 256, BK = 64, HALF = 128, HTB = HALF * BK * 2  , STAGE_BYTES = 8 * HTB, NXCD = 8, WGM = 8;

__host__ __device__ __forceinline__ int lds_byte(int r, int c) { const int st = (r >> 4) * 2 + (c >> 5), rr = r & 15, cc = c & 31, ob = rr * 64 + cc * 2; return st * 1024 + (ob ^ (((ob >> 9) & 1) << 5)); }
__host__ __device__ __forceinline__ void stage_rc(int b, int& R, int& C) { const int st = b / 1024, sb = b % 1024, swz = sb ^ (((sb >> 9) & 1) << 5); R = (st >> 1) * 16 + swz / 64; C = (st & 1) * 32 + (swz % 64) / 2; }
__host__ __device__ __forceinline__ int perm32(int rho) { const int n = rho >> 4, i = rho & 15; return 8 * (i >> 2) + 4 * n + (i & 3); }

struct Unit { int pm, pn; };
struct Gemm { const bf16_t* A; const bf16_t* Bt; int M, N, K; };

struct StaticOrder {
    int nM, nN, nwg, G, c;
    __host__ __device__ void init(int M, int N, int G_, int c_) { nM = M / BM; nN = N / BM; nwg = nM * nN; G = G_; c = c_; }
    __host__ __device__ bool next(int i, Unit& u) const {
        const long L = (long)i * G + c; if (L >= nwg) return false;
        int wgid = (int)L; { const int q = nwg / NXCD, r = nwg % NXCD, xcd = wgid % NXCD, off = wgid / NXCD; wgid = (xcd < r ? xcd * (q + 1) : r * (q + 1) + (xcd - r) * q) + off; }
        const int nig = WGM * nN, gid = wgid / nig, fm = gid * WGM, gsz = (nM - fm) < WGM ? (nM - fm) : WGM;
        u.pm = fm + ((wgid % nig) % gsz); u.pn = (wgid % nig) / gsz; return true;
    }
    __device__ __forceinline__ void a_ready(const Unit&) const {}
    __device__ __forceinline__ void done(const Unit&) const {}
};

__device__ __forceinline__ unsigned cvt_pk_bf16(float lo, float hi) { unsigned r; asm volatile("v_cvt_pk_bf16_f32 %0, %1, %2" : "=v"(r) : "v"(lo), "v"(hi)); return r; }
typedef int v8i32 __attribute__((ext_vector_type(8))); typedef int v4i32 __attribute__((ext_vector_type(4)));
__device__ __forceinline__ v8i32 cat8(bf16x8 lo, bf16x8 hi) { const v4i32 a = __builtin_bit_cast(v4i32, lo), b = __builtin_bit_cast(v4i32, hi); return __builtin_shufflevector(a, b, 0, 1, 2, 3, 4, 5, 6, 7); }
template <class Epi, class Sched, bool ALIGN_EPI = false, bool SP2 = false, bool FP8 = false>
__device__ __forceinline__ void gemm_phase(PG8_LAS unsigned char* lds, const Gemm g, const Sched& S, const Epi& E) {
    const int tid = opaque_tid(), wid = __builtin_amdgcn_readfirstlane(tid >> 6), lane = tid & 63, wr = wid >> 2, wc = wid & 3, fr = lane & 15, fq = lane >> 4;
    const int K = g.K, nt = K / BK;
    unsigned voffA[2], voffB[2];
#pragma unroll
    for (int i = 0; i < 2; ++i) { int R, C; stage_rc(tid * 16 + i * 8192, R, C); const int Rb = Epi::PERM ? ((R & ~31) + perm32(R & 31)) : R;
        voffA[i] = (unsigned)(R * K + C) * 2u; voffB[i] = (unsigned)(Rb * K + C) * 2u; }
    const size_t kstep = (size_t)(BK * 2);
    const size_t hstep = (size_t)HALF * K * 2;
    const size_t tstep = 2 * hstep;
    const unsigned ldsw = (unsigned)wid * 1024u;
    const int aoff_ = lds_byte(wr * 64 + fr, fq * 8), boff_ = lds_byte(wc * 32 + fr, fq * 8);
#define aoff (FP8 ? ({ int l_ = aoff_; asm volatile("" : "+v"(l_)); l_; }) : aoff_)
#define boff (FP8 ? ({ int l_ = boff_; asm volatile("" : "+v"(l_)); l_; }) : boff_)
#define PG8_SA(b, h) (((b) * 2 + (h)) * HTB)
#define PG8_SB(b, h) ((4 + (b) * 2 + (h)) * HTB)
#define PG8_STAGE(bufoff, gbase, voff) do { _Pragma("unroll") for (int _i = 0; _i < 2; ++_i) \
        __builtin_amdgcn_global_load_lds((const unsigned*)((const char*)(gbase) + (voff)[_i]), (PG8_LAS unsigned*)(lds + (bufoff) + ldsw + _i * 8192), 16, 0, 0); } while (0)
#define PG8_LDA(dst, b, h) do { _Pragma("unroll") for (int m = 0; m < 4; ++m) _Pragma("unroll") for (int k = 0; k < 2; ++k) dst[m][k] = *(const PG8_LAS bf16x8*)(lds + PG8_SA(b, h) + aoff + m * 2048 + k * 1024); } while (0)
#define PG8_LDB(dst, b, h) do { _Pragma("unroll") for (int n = 0; n < 2; ++n) _Pragma("unroll") for (int k = 0; k < 2; ++k) dst[n][k] = *(const PG8_LAS bf16x8*)(lds + PG8_SB(b, h) + boff + n * 2048 + k * 1024); } while (0)
#define PG8_MMA(ai, bj, At, Bt) do { __builtin_amdgcn_s_setprio(1); if constexpr (FP8) { _Pragma("unroll") for (int m = 0; m < 4; ++m) _Pragma("unroll") for (int n = 0; n < 2; ++n) \
        acc[ai][bj][m][n] = __builtin_amdgcn_mfma_scale_f32_16x16x128_f8f6f4(cat8(Bt[n][0], Bt[n][1]), cat8(At[m][0], At[m][1]), acc[ai][bj][m][n], 0, 0, 0, 0x7f7f7f7f, 0, 0x7f7f7f7f); } \
        else { _Pragma("unroll") for (int m = 0; m < 4; ++m) _Pragma("unroll") for (int n = 0; n < 2; ++n) _Pragma("unroll") for (int k = 0; k < 2; ++k) \
        acc[ai][bj][m][n] = __builtin_amdgcn_mfma_f32_16x16x32_bf16(Bt[n][k], At[m][k], acc[ai][bj][m][n], 0, 0, 0); } __builtin_amdgcn_s_setprio(0); } while (0)
#define PG8_WAIT_V(n) asm volatile("s_waitcnt vmcnt(" #n ")" ::: "memory")
#define PG8_WAIT_L(n) asm volatile("s_waitcnt lgkmcnt(" #n ")" ::: "memory")
#define PG8_BAR __builtin_amdgcn_s_barrier()
#define PG8_SCHED __builtin_amdgcn_sched_barrier(0)
    Unit cur, nxt; int ui = 0;
    if (!S.next(0, cur)) return;
    f32x4 acc[2][2][4][2];
#pragma unroll
    for (int a = 0; a < 2; ++a)
#pragma unroll
        for (int b = 0; b < 2; ++b)
#pragma unroll
            for (int m = 0; m < 4; ++m)
#pragma unroll
                for (int n = 0; n < 2; ++n) acc[a][b][m][n] = (f32x4){0.f, 0.f, 0.f, 0.f};
    bf16x8 At[4][2], B0[2][2], B1[2][2];
    const char* cA = (const char*)g.A + (size_t)cur.pm * tstep; const char* cB = (const char*)g.Bt + (size_t)cur.pn * tstep;
    S.a_ready(cur);
    if constexpr (SP2) {
        PG8_STAGE(PG8_SB(0, 0), cB, voffB); PG8_STAGE(PG8_SB(0, 1), cB + hstep, voffB); PG8_STAGE(PG8_SA(0, 0), cA, voffA); PG8_STAGE(PG8_SA(0, 1), cA + hstep, voffA);
        if (wr == 1) PG8_BAR;
        PG8_WAIT_V(2); PG8_BAR;
        PG8_STAGE(PG8_SB(1, 0), cB + kstep, voffB); PG8_STAGE(PG8_SA(1, 0), cA + kstep, voffA); PG8_STAGE(PG8_SB(1, 1), cB + hstep + kstep, voffB);
        PG8_WAIT_V(6); PG8_BAR;
    } else {
        PG8_STAGE(PG8_SB(0, 0), cB, voffB); PG8_STAGE(PG8_SA(0, 0), cA, voffA); PG8_STAGE(PG8_SB(0, 1), cB + hstep, voffB); PG8_STAGE(PG8_SA(0, 1), cA + hstep, voffA);
        if (wr == 1) PG8_BAR;
        PG8_WAIT_V(4); PG8_BAR;
        PG8_STAGE(PG8_SB(1, 0), cB + kstep, voffB); PG8_STAGE(PG8_SA(1, 0), cA + kstep, voffA); PG8_STAGE(PG8_SB(1, 1), cB + hstep + kstep, voffB);
        PG8_WAIT_V(6); PG8_BAR;
    }
    for (;;) {
        const bool has_next = S.next(ui + 1, nxt);
        const char* nA = has_next ? (const char*)g.A + (size_t)nxt.pm * tstep : cA; const char* nB = has_next ? (const char*)g.Bt + (size_t)nxt.pn * tstep : cB;
        for (int t = 0; t < nt; t += 2) {
            const bool last = (t == nt - 2);
            const char* a1 = cA + (size_t)(t + 1) * kstep;
            const char* a2 = last ? nA : cA + (size_t)(t + 2) * kstep; const char* b2 = last ? nB : cB + (size_t)(t + 2) * kstep;
            const char* a3 = a2 + kstep; const char* b3 = b2 + kstep;
            if (last && has_next) S.a_ready(nxt);
            if constexpr (SP2) {
            PG8_LDB(B0, 0, 0); PG8_LDB(B1, 0, 1); PG8_SCHED; PG8_LDA(At, 0, 0); PG8_STAGE(PG8_SA(1, 1), a1 + hstep, voffA);
            PG8_WAIT_V(8); PG8_WAIT_L(0); PG8_BAR; PG8_MMA(0, 0, At, B0); PG8_MMA(0, 1, At, B1); PG8_BAR; PG8_SCHED;
            PG8_LDA(At, 0, 1); PG8_STAGE(PG8_SB(0, 0), b2, voffB); PG8_STAGE(PG8_SB(0, 1), b2 + hstep, voffB); PG8_STAGE(PG8_SA(0, 0), a2, voffA);
            PG8_WAIT_V(8); PG8_WAIT_L(0); PG8_BAR; PG8_MMA(1, 0, At, B0); PG8_MMA(1, 1, At, B1); PG8_BAR; PG8_SCHED;
            PG8_LDB(B0, 1, 0); PG8_LDB(B1, 1, 1); PG8_SCHED; PG8_LDA(At, 1, 0); PG8_STAGE(PG8_SA(0, 1), a2 + hstep, voffA);
            PG8_WAIT_V(8); PG8_WAIT_L(0); PG8_BAR; PG8_MMA(0, 0, At, B0); PG8_MMA(0, 1, At, B1); PG8_BAR; PG8_SCHED;
            PG8_LDA(At, 1, 1); PG8_STAGE(PG8_SB(1, 0), b3, voffB); PG8_STAGE(PG8_SB(1, 1), b3 + hstep, voffB); PG8_STAGE(PG8_SA(1, 0), a3, voffA);
            PG8_WAIT_V(8); PG8_WAIT_L(0); PG8_BAR; PG8_MMA(1, 0, At, B0); PG8_MMA(1, 1, At, B1); PG8_BAR; PG8_SCHED;
            } else {
            PG8_LDB(B0, 0, 0); PG8_SCHED; PG8_LDA(At, 0, 0); PG8_STAGE(PG8_SA(1, 1), a1 + hstep, voffA);
            PG8_WAIT_L(8); PG8_BAR; PG8_WAIT_L(0); PG8_MMA(0, 0, At, B0); PG8_BAR; PG8_SCHED;
            PG8_LDB(B1, 0, 1); PG8_STAGE(PG8_SB(0, 0), b2, voffB);
            PG8_BAR; PG8_WAIT_L(0); PG8_MMA(0, 1, At, B1); PG8_BAR;
            PG8_LDA(At, 0, 1); PG8_STAGE(PG8_SA(0, 0), a2, voffA);
            PG8_BAR; PG8_WAIT_L(0); PG8_MMA(1, 0, At, B0); PG8_BAR; PG8_SCHED;
            PG8_STAGE(PG8_SB(0, 1), b2 + hstep, voffB);
            PG8_WAIT_V(6); PG8_BAR; PG8_MMA(1, 1, At, B1); PG8_BAR;
            PG8_LDB(B0, 1, 0); PG8_SCHED; PG8_LDA(At, 1, 0); PG8_STAGE(PG8_SA(0, 1), a2 + hstep, voffA);
            PG8_WAIT_L(8); PG8_BAR; PG8_WAIT_L(0); PG8_MMA(0, 0, At, B0); PG8_BAR; PG8_SCHED;
            PG8_LDB(B1, 1, 1); PG8_STAGE(PG8_SB(1, 0), b3, voffB);
            PG8_BAR; PG8_WAIT_L(0); PG8_MMA(0, 1, At, B1); PG8_BAR;
            PG8_LDA(At, 1, 1); PG8_STAGE(PG8_SA(1, 0), a3, voffA);
            PG8_BAR; PG8_WAIT_L(0); PG8_MMA(1, 0, At, B0); PG8_BAR; PG8_SCHED;
            PG8_STAGE(PG8_SB(1, 1), b3 + hstep, voffB);
            PG8_WAIT_V(6); PG8_BAR; PG8_MMA(1, 1, At, B1); PG8_BAR;
            }
        }
        if constexpr (ALIGN_EPI) { if (wr == 0) PG8_BAR; }
        if constexpr (!Epi::AFTER_DRAIN) { const int lo_ = opaque_tid() & 63; E(acc, cur, wr, wc, lo_ & 15, lo_ >> 4); S.done(cur); }
        if (!has_next) break;
#pragma unroll
        for (int a = 0; a < 2; ++a)
#pragma unroll
            for (int b = 0; b < 2; ++b)
#pragma unroll
                for (int m = 0; m < 4; ++m)
#pragma unroll
                    for (int n = 0; n < 2; ++n) acc[a][b][m][n] = (f32x4){0.f, 0.f, 0.f, 0.f};
        cur = nxt; cA = nA; cB = nB; ++ui;
        if constexpr (ALIGN_EPI) { if (wr == 1) PG8_BAR; }
    }
    PG8_WAIT_V(0);
    if constexpr (!ALIGN_EPI) { if (wr == 0) PG8_BAR; }
    PG8_BAR;
    if constexpr (Epi::AFTER_DRAIN) { const int lo_ = opaque_tid() & 63; E.fused(acc, cur, wr, wc, lo_ & 15, lo_ >> 4, lds, wid, lo_); S.done(cur); }
#undef aoff
#undef boff
#undef PG8_SA
#undef PG8_SB
#undef PG8_STAGE
#undef PG8_LDA
#undef PG8_LDB
#undef PG8_MMA
#undef PG8_WAIT_V
#undef PG8_WAIT_L
#undef PG8_BAR
#undef PG8_SCHED
}
}

namespace pg8 {
__device__ __forceinline__ u32x4 pack8(const f32x4& a, const f32x4& b) { u32x4 w; w.x = cvt_pk_bf16(a[0], a[1]); w.y = cvt_pk_bf16(a[2], a[3]); w.z = cvt_pk_bf16(b[0], b[1]); w.w = cvt_pk_bf16(b[2], b[3]); return w; }
struct EpiG1 {
    static constexpr bool PERM = true, AFTER_DRAIN = false;
    bf16_t *za, *q, *k, *v; const float* cs;
    __device__ __forceinline__ void operator()(const f32x4 (&acc)[2][2][4][2], const Unit& u, int wr, int wc, int fr, int fq) const {
        const int row0 = u.pm * BM + wr * 64 + fr, pn = u.pn, cw = wc * 32 + 8 * fq;
        if (pn < 4 || pn >= 8) {
            bf16_t* base = pn < 4 ? za : v; const int ld = pn < 4 ? 1024 : 512, ct = pn < 4 ? pn * 256 : (pn - 8) * 256;
#pragma unroll
            for (int ai = 0; ai < 2; ++ai)
#pragma unroll
                for (int m = 0; m < 4; ++m) { bf16_t* rowp = base + (size_t)(row0 + ai * HALF + m * 16) * ld + ct + cw;
#pragma unroll
                    for (int bj = 0; bj < 2; ++bj) *(u32x4*)(rowp + bj * HALF) = pack8(acc[ai][bj][m][0], acc[ai][bj][m][1]); }
        } else {
            const bool isq = pn < 6; bf16_t* base = isq ? q : k; const int ct = (pn - (isq ? 4 : 6)) * 256; const float sc = isq ? 0.18033688011112042f : 1.f;
            const bool ropew = (wc & 1) == 0;
            const float sgn = fq == 0 ? -1.f : 1.f;
#pragma unroll
            for (int ai = 0; ai < 2; ++ai)
#pragma unroll
                for (int m = 0; m < 4; ++m) { const int row = row0 + ai * HALF + m * 16; bf16_t* rowp = base + (size_t)row * 512 + ct + cw;
                    f32x4 c0 = {1.f, 1.f, 1.f, 1.f}, c1 = c0, s0 = {0.f, 0.f, 0.f, 0.f}, s1 = s0;
                    if (ropew && fq < 2) { const f32x4* cp = (const f32x4*)(cs + (size_t)row * 16); c0 = cp[0]; c1 = cp[1]; s0 = cp[2] * sgn; s1 = cp[3] * sgn; }
#pragma unroll
                    for (int bj = 0; bj < 2; ++bj) { f32x4 a = acc[ai][bj][m][0], b = acc[ai][bj][m][1];
                        if (ropew) { f32x4 pa, pb;
#pragma unroll
                            for (int i = 0; i < 4; ++i) { pa[i] = __shfl_xor(a[i], 16); pb[i] = __shfl_xor(b[i], 16); }
                            a = a * c0 + pa * s0; b = b * c1 + pb * s1; }
                        a = a * sc; b = b * sc;
                        *(u32x4*)(rowp + bj * HALF) = pack8(a, b); } }
        }
    }
};
__device__ __forceinline__ void unpack8(const u32x4 w, f32x4& a, f32x4& b) { a[0] = __uint_as_float(w.x << 16); a[1] = __uint_as_float(w.x & 0xffff0000u); a[2] = __uint_as_float(w.y << 16); a[3] = __uint_as_float(w.y & 0xffff0000u);
    b[0] = __uint_as_float(w.z << 16); b[1] = __uint_as_float(w.z & 0xffff0000u); b[2] = __uint_as_float(w.w << 16); b[3] = __uint_as_float(w.w & 0xffff0000u); }
struct EpiOutF {
    static constexpr bool PERM = true, AFTER_DRAIN = false;
    const bf16_t* xb; const float* rx; bf16_t* hb;
    __device__ __forceinline__ void operator()(const f32x4 (&acc)[2][2][4][2], const Unit& u, int wr, int wc, int fr, int fq) const {
        const int row0 = u.pm * BM + wr * 64 + fr, col0 = u.pn * BM + wc * 32 + 8 * fq;
#pragma unroll
        for (int ai = 0; ai < 2; ++ai)
#pragma unroll
            for (int m = 0; m < 4; ++m) { const int row = row0 + ai * HALF + m * 16; const float r = rx[row]; const size_t off = (size_t)row * 1024 + col0;
#pragma unroll
                for (int bj = 0; bj < 2; ++bj) { f32x4 x0, x1; unpack8(*(const u32x4*)(xb + off + bj * HALF), x0, x1);
                    const f32x4 h0 = x0 * r + acc[ai][bj][m][0], h1 = x1 * r + acc[ai][bj][m][1];
                    *(u32x4*)(hb + off + bj * HALF) = pack8(h0, h1); } }
    }
};
__device__ __forceinline__ f32x4 sig4(f32x4 v) { f32x4 r;
#pragma unroll
    for (int i = 0; i < 4; ++i) r[i] = __builtin_amdgcn_rcpf(1.f + __expf(-v[i]));
    return r; }
struct EpiGateFused {
    static constexpr bool PERM = true, AFTER_DRAIN = false;
    bf16_t* h3b; const bf16_t* h2b; const bf16_t* pp; float cs;
    __device__ __forceinline__ void operator()(const f32x4 (&acc)[2][2][4][2], const Unit& u, int wr, int wc, int fr, int fq) const {
        const int row0 = u.pm * BM + wr * 64 + fr, col0 = u.pn * BM + wc * 32 + 8 * fq;
#pragma unroll
        for (int ai = 0; ai < 2; ++ai)
#pragma unroll
            for (int m = 0; m < 4; ++m) { const int row = row0 + ai * HALF + m * 16; const float rs = cs; const size_t off = (size_t)row * 1024 + col0;
#pragma unroll
                for (int bj = 0; bj < 2; ++bj) { f32x4 g0, g1, q0, q1; unpack8(*(const u32x4*)(pp + off + bj * HALF), g0, g1); unpack8(*(const u32x4*)(h2b + off + bj * HALF), q0, q1);
                    *(u32x4*)(h3b + off + bj * HALF) = pack8(q0 + sig4(acc[ai][bj][m][0] * rs) * g0, q1 + sig4(acc[ai][bj][m][1] * rs) * g1); } }
    }
};
struct EpiStoreBf16 {
    static constexpr bool PERM = true, AFTER_DRAIN = false;
    bf16_t* o;
    __device__ __forceinline__ void operator()(const f32x4 (&acc)[2][2][4][2], const Unit& u, int wr, int wc, int fr, int fq) const {
        const int row0 = u.pm * BM + wr * 64 + fr, col0 = u.pn * BM + wc * 32 + 8 * fq;
#pragma unroll
        for (int ai = 0; ai < 2; ++ai)
#pragma unroll
            for (int m = 0; m < 4; ++m) { const size_t off = (size_t)(row0 + ai * HALF + m * 16) * 1024 + col0;
#pragma unroll
                for (int bj = 0; bj < 2; ++bj) *(u32x4*)(o + off + bj * HALF) = pack8(acc[ai][bj][m][0], acc[ai][bj][m][1]); }
    }
};
}


namespace pg8 {
struct GUnit { int e, rb, pn; };
template <class Epi, class Sched, bool ALIGN_EPI, bool GATHER, bool FP8 = false>
__device__ __forceinline__ void gemm_phase_g(PG8_LAS unsigned char* lds, const bf16_t* A, const int K, const Sched& S, const Epi& E) {
    const int tid = opaque_tid(), wid = __builtin_amdgcn_readfirstlane(tid >> 6), lane = tid & 63, wr = wid >> 2, wc = wid & 3, fr = lane & 15, fq = lane >> 4;
    const int nt = K / BK;
    unsigned voffB0[2]; int RA[2]; unsigned CA2[2];
#pragma unroll
    for (int i = 0; i < 2; ++i) { int R, C; stage_rc(tid * 16 + i * 8192, R, C); const int Rb = Epi::PERM ? ((R & ~31) + perm32(R & 31)) : R;
        voffB0[i] = (unsigned)(Rb * K + C) * 2u; RA[i] = R; CA2[i] = (unsigned)C * 2u; }
    const size_t kstep = (size_t)(BK * 2);
    const size_t hstep = (size_t)HALF * K * 2;
    const unsigned ldsw = (unsigned)wid * 1024u;
    const int aoff_ = lds_byte(wr * 64 + fr, fq * 8), boff_ = lds_byte(wc * 32 + fr, fq * 8);
#define aoff (FP8 ? ({ int l_ = aoff_; asm volatile("" : "+v"(l_)); l_; }) : aoff_)
#define boff (FP8 ? ({ int l_ = boff_; asm volatile("" : "+v"(l_)); l_; }) : boff_)
#define PG8_SA(b, h) (((b) * 2 + (h)) * HTB)
#define PG8_SB(b, h) ((4 + (b) * 2 + (h)) * HTB)
#define PG8_STAGE(bufoff, gbase, voff) do { _Pragma("unroll") for (int _i = 0; _i < 2; ++_i) \
        __builtin_amdgcn_global_load_lds((const unsigned*)((const char*)(gbase) + (voff)[_i]), (PG8_LAS unsigned*)(lds + (bufoff) + ldsw + _i * 8192), 16, 0, 0); } while (0)
#define PG8_STAGE_A1(bufoff, gbase) do { if constexpr (GATHER) { PG8_STAGE(bufoff, gbase, vc1); } else { const unsigned v1_[2] = {vc0[0] + (unsigned)hstep, vc0[1] + (unsigned)hstep}; PG8_STAGE(bufoff, gbase, v1_); } } while (0)
#define PG8_LDA(dst, b, h) do { _Pragma("unroll") for (int m = 0; m < 4; ++m) _Pragma("unroll") for (int k = 0; k < 2; ++k) dst[m][k] = *(const PG8_LAS bf16x8*)(lds + PG8_SA(b, h) + aoff + m * 2048 + k * 1024); } while (0)
#define PG8_LDB(dst, b, h) do { _Pragma("unroll") for (int n = 0; n < 2; ++n) _Pragma("unroll") for (int k = 0; k < 2; ++k) dst[n][k] = *(const PG8_LAS bf16x8*)(lds + PG8_SB(b, h) + boff + n * 2048 + k * 1024); } while (0)
#define PG8_MMA(ai, bj, At, Bt) do { __builtin_amdgcn_s_setprio(1); if constexpr (FP8) { _Pragma("unroll") for (int m = 0; m < 4; ++m) _Pragma("unroll") for (int n = 0; n < 2; ++n) \
        acc[ai][bj][m][n] = __builtin_amdgcn_mfma_scale_f32_16x16x128_f8f6f4(cat8(Bt[n][0], Bt[n][1]), cat8(At[m][0], At[m][1]), acc[ai][bj][m][n], 0, 0, 0, 0x7f7f7f7f, 0, 0x7f7f7f7f); } \
        else { _Pragma("unroll") for (int m = 0; m < 4; ++m) _Pragma("unroll") for (int n = 0; n < 2; ++n) _Pragma("unroll") for (int k = 0; k < 2; ++k) \
        acc[ai][bj][m][n] = __builtin_amdgcn_mfma_f32_16x16x32_bf16(Bt[n][k], At[m][k], acc[ai][bj][m][n], 0, 0, 0); } __builtin_amdgcn_s_setprio(0); } while (0)
#define PG8_WAIT_V(n) asm volatile("s_waitcnt vmcnt(" #n ")" ::: "memory")
#define PG8_WAIT_L(n) asm volatile("s_waitcnt lgkmcnt(" #n ")" ::: "memory")
#define PG8_BAR __builtin_amdgcn_s_barrier()
#define PG8_SCHED __builtin_amdgcn_sched_barrier(0)
    GUnit cur, nxt; int ui = 0;
    if (!S.next(0, cur)) return;
    f32x4 acc[2][2][4][2];
#pragma unroll
    for (int a = 0; a < 2; ++a)
#pragma unroll
        for (int b = 0; b < 2; ++b)
#pragma unroll
            for (int m = 0; m < 4; ++m)
#pragma unroll
                for (int n = 0; n < 2; ++n) acc[a][b][m][n] = (f32x4){0.f, 0.f, 0.f, 0.f};
    bf16x8 At[4][2], B0[2][2], B1[2][2];
    unsigned vc0[2], vc1[2];
#pragma unroll
    for (int i = 0; i < 2; ++i) { vc0[i] = S.arow_off(cur, RA[i]) + CA2[i]; vc1[i] = S.arow_off(cur, RA[i] + HALF) + CA2[i]; }
    const char* const kA = (const char*)A; const char* cB = S.bbase(cur);
    PG8_STAGE(PG8_SB(0, 0), cB, voffB0); PG8_STAGE(PG8_SB(0, 1), cB + hstep, voffB0); PG8_STAGE(PG8_SA(0, 0), kA, vc0); PG8_STAGE_A1(PG8_SA(0, 1), kA);
    if (wr == 1) PG8_BAR;
    PG8_WAIT_V(2); PG8_BAR;
    PG8_STAGE(PG8_SB(1, 0), cB + kstep, voffB0); PG8_STAGE(PG8_SA(1, 0), kA + kstep, vc0); PG8_STAGE(PG8_SB(1, 1), cB + hstep + kstep, voffB0);
    PG8_WAIT_V(6); PG8_BAR;
    for (;;) {
        const bool has_next = S.next(ui + 1, nxt);
        const char* nB = has_next ? S.bbase(nxt) : cB;
        if (GATHER && has_next) {
            int tg = tid; asm volatile("" : "+v"(tg));
#pragma unroll
            for (int i = 0; i < 2; ++i) { int R, C; stage_rc(tg * 16 + i * 8192, R, C);
                __builtin_amdgcn_global_load_lds((const unsigned*)S.row_ptr(nxt, R), (PG8_LAS unsigned*)(lds + IDXBUF + ((2 * i) * 8 + wid) * 256), 4, 0, 0);
                __builtin_amdgcn_global_load_lds((const unsigned*)S.row_ptr(nxt, R + HALF), (PG8_LAS unsigned*)(lds + IDXBUF + ((2 * i + 1) * 8 + wid) * 256), 4, 0, 0); }
        }
        for (int t = 0; t < nt; t += 2) {
            const bool last = (t == nt - 2);
            unsigned voffB[2];
            { int tb = tid; asm volatile("" : "+v"(tb));
#pragma unroll
              for (int i = 0; i < 2; ++i) { int R, C; stage_rc(tb * 16 + i * 8192, R, C); const int Rb = Epi::PERM ? ((R & ~31) + perm32(R & 31)) : R; voffB[i] = (unsigned)(Rb * K + C) * 2u; } }
            const char* a1 = kA + (size_t)(t + 1) * kstep;
            const char* a2 = last ? kA : kA + (size_t)(t + 2) * kstep; const char* b2 = last ? nB : cB + (size_t)(t + 2) * kstep;
            const char* a3 = a2 + kstep; const char* b3 = b2 + kstep;
            PG8_STAGE_A1(PG8_SA(1, 1), a1);
            if (last && has_next) {
                int tt = tid; asm volatile("" : "+v"(tt));
#pragma unroll
                for (int i = 0; i < 2; ++i) { int R, C; stage_rc(tt * 16 + i * 8192, R, C); const unsigned c2 = (unsigned)C * 2u;
                    if (GATHER) { const unsigned i0 = *(const PG8_LAS unsigned*)(lds + IDXBUF + ((2 * i) * 8 + wid) * 256 + lane * 4), i1 = *(const PG8_LAS unsigned*)(lds + IDXBUF + ((2 * i + 1) * 8 + wid) * 256 + lane * 4);
                        vc0[i] = i0 * (unsigned)(K * 2) + c2; vc1[i] = i1 * (unsigned)(K * 2) + c2; }
                    else { vc0[i] = S.arow_off(nxt, R) + c2; vc1[i] = S.arow_off(nxt, R + HALF) + c2; } }
            }
            PG8_LDB(B0, 0, 0); PG8_LDB(B1, 0, 1); PG8_SCHED; PG8_LDA(At, 0, 0);
            PG8_WAIT_V(8); PG8_WAIT_L(0); PG8_BAR; PG8_MMA(0, 0, At, B0); PG8_MMA(0, 1, At, B1); PG8_BAR; PG8_SCHED;
            PG8_LDA(At, 0, 1); PG8_STAGE(PG8_SB(0, 0), b2, voffB); PG8_STAGE(PG8_SB(0, 1), b2 + hstep, voffB); PG8_STAGE(PG8_SA(0, 0), a2, vc0);
            PG8_WAIT_V(8); PG8_WAIT_L(0); PG8_BAR; PG8_MMA(1, 0, At, B0); PG8_MMA(1, 1, At, B1); PG8_BAR; PG8_SCHED;
            PG8_LDB(B0, 1, 0); PG8_LDB(B1, 1, 1); PG8_SCHED; PG8_LDA(At, 1, 0); PG8_STAGE_A1(PG8_SA(0, 1), a2);
            PG8_WAIT_V(8); PG8_WAIT_L(0); PG8_BAR; PG8_MMA(0, 0, At, B0); PG8_MMA(0, 1, At, B1); PG8_BAR; PG8_SCHED;
            PG8_LDA(At, 1, 1); PG8_STAGE(PG8_SB(1, 0), b3, voffB); PG8_STAGE(PG8_SB(1, 1), b3 + hstep, voffB); PG8_STAGE(PG8_SA(1, 0), a3, vc0);
            PG8_WAIT_V(8); PG8_WAIT_L(0); PG8_BAR; PG8_MMA(1, 0, At, B0); PG8_MMA(1, 1, At, B1); PG8_BAR; PG8_SCHED;
        }
        if constexpr (ALIGN_EPI) { if (wr == 0) PG8_BAR; }
        { const int lo_ = opaque_tid() & 63; E(acc, cur, wr, wc, lo_ & 15, lo_ >> 4); }
        if (!has_next) break;
#pragma unroll
        for (int a = 0; a < 2; ++a)
#pragma unroll
            for (int b = 0; b < 2; ++b)
#pragma unroll
                for (int m = 0; m < 4; ++m)
#pragma unroll
                    for (int n = 0; n < 2; ++n) acc[a][b][m][n] = (f32x4){0.f, 0.f, 0.f, 0.f};
        cur = nxt; cB = nB; ++ui;
        if constexpr (ALIGN_EPI) { if (wr == 1) PG8_BAR; }
    }
    PG8_WAIT_V(0);
    if constexpr (!ALIGN_EPI) { if (wr == 0) PG8_BAR; }
    PG8_BAR;
#undef aoff
#undef boff
#undef PG8_SA
#undef PG8_SB
#undef PG8_STAGE
#undef PG8_STAGE_A1
#undef PG8_LDA
#undef PG8_LDB
#undef PG8_MMA
#undef PG8_WAIT_V
#undef PG8_WAIT_L
#undef PG8_BAR
#undef PG8_SCHED
}
struct MoeOrder {
    const PG8_LAS unsigned* tab; int npn, vcu, G; const int* rowtok; const bf16_t* Bt; size_t bstride  ; int K; bool gather; int rep  ; const int* ident; const int* zero_word;
    __device__ __forceinline__ bool next(int i, GUnit& u) const {
        const unsigned w = tab[384 + i]; if (w == ~0u) return false; u.e = (int)(w >> 16); u.rb = (int)((w >> 4) & 0xfffu); u.pn = (int)(w & 15u); return true;
    }
    __device__ __forceinline__ unsigned unit_at(int i) const {
        int L = i * G + vcu; const int total = (int)tab[256 + NE_P1] * npn; if (L >= total * rep) return ~0u; if (L >= total) L -= total;
        const int tile = L / npn; const int pn = L - tile * npn;
        int lo = 0, hi = NE_P1;
        while (hi - lo > 1) { const int mid = (lo + hi) >> 1; if ((int)tab[256 + mid] <= tile) lo = mid; else hi = mid; }
        return ((unsigned)lo << 16) | ((unsigned)(tile - (int)tab[256 + lo]) << 4) | (unsigned)pn;
    }
    __device__ __forceinline__ unsigned arow_off(const GUnit& u, int R) const {
        const int r = u.rb * 256 + R;
        if (gather) { int idx = r; if (u.e < NE_P1 - 1) idx = (r < (int)tab[128 + u.e]) ? rowtok[u.e * ECAP_ + r] : 0; return (unsigned)idx * (unsigned)(K * 2); }
        return ((unsigned)tab[u.e] + (unsigned)r) * (unsigned)(K * 2);
    }
    __device__ __forceinline__ const int* row_ptr(const GUnit& u, int R) const { const int r = u.rb * 256 + R; if (u.e == NE_P1 - 1) return ident + r; return (r < (int)tab[128 + u.e]) ? rowtok + u.e * ECAP_ + r : zero_word; }
    __device__ __forceinline__ const char* bbase(const GUnit& u) const { return (const char*)(Bt + (size_t)u.e * bstride + (size_t)u.pn * 256 * K); }
};
__device__ __forceinline__ f32x4 silu_mul(f32x4 g, f32x4 u) { f32x4 r;
#pragma unroll
    for (int i = 0; i < 4; ++i) r[i] = g[i] * __builtin_amdgcn_rcpf(1.f + __expf(-g[i])) * u[i];
    return r; }
struct EpiUpG {
    static constexpr bool PERM = true, AFTER_DRAIN = false;
    unsigned char* act8; const PG8_LAS unsigned* tab; float wscale, ascale;
    __device__ __forceinline__ void operator()(const f32x4 (&acc)[2][2][4][2], const GUnit& u, int wr, int wc, int fr, int fq) const {
        const int n = (int)tab[128 + u.e]; const size_t base = tab[u.e]; const float rs = wscale;
#pragma unroll
        for (int ai = 0; ai < 2; ++ai)
#pragma unroll
            for (int m = 0; m < 4; ++m) { const int r = u.rb * 256 + ai * HALF + wr * 64 + m * 16 + fr;
                if (r < n) {
                    const f32x4 a0 = silu_mul(acc[ai][0][m][0] * rs, acc[ai][1][m][0] * rs) * ascale, a1 = silu_mul(acc[ai][0][m][1] * rs, acc[ai][1][m][1] * rs) * ascale;
                    int lo = __builtin_amdgcn_cvt_pk_fp8_f32(a0[0], a0[1], 0, false); lo = __builtin_amdgcn_cvt_pk_fp8_f32(a0[2], a0[3], lo, true);
                    int hi = __builtin_amdgcn_cvt_pk_fp8_f32(a1[0], a1[1], 0, false); hi = __builtin_amdgcn_cvt_pk_fp8_f32(a1[2], a1[3], hi, true);
                    typedef int i32x2 __attribute__((ext_vector_type(2))); *(i32x2*)(act8 + (base + r) * 256 + u.pn * 128 + wc * 32 + 8 * fq) = (i32x2){lo, hi}; } }
    }
};
struct EpiDownG {
    static constexpr bool PERM = true, AFTER_DRAIN = false;
    unsigned char* yb; float* out; const PG8_LAS unsigned* tab; float yscale;
    __device__ __forceinline__ void operator()(const f32x4 (&acc)[2][2][4][2], const GUnit& u, int wr, int wc, int fr, int fq) const {
        const int n = (int)tab[128 + u.e]; const size_t base = tab[u.e]; const int col0 = u.pn * 256 + wc * 32 + 8 * fq;
#pragma unroll
        for (int ai = 0; ai < 2; ++ai)
#pragma unroll
            for (int m = 0; m < 4; ++m) { const int r = u.rb * 256 + ai * HALF + wr * 64 + m * 16 + fr;
                if (r < n) {
#pragma unroll
                        for (int bj = 0; bj < 2; ++bj) { const f32x4 a = acc[ai][bj][m][0] * yscale, b = acc[ai][bj][m][1] * yscale;
                            int lo = __builtin_amdgcn_cvt_pk_fp8_f32(a[0], a[1], 0, false); lo = __builtin_amdgcn_cvt_pk_fp8_f32(a[2], a[3], lo, true);
                            int hi = __builtin_amdgcn_cvt_pk_fp8_f32(b[0], b[1], 0, false); hi = __builtin_amdgcn_cvt_pk_fp8_f32(b[2], b[3], hi, true);
                            typedef int i32x2 __attribute__((ext_vector_type(2)));
                            *(i32x2*)(yb + (base + r) * 1024 + col0 + bj * HALF) = (i32x2){lo, hi}; }
                    } }
    }
};
}

namespace attn_body {
using bf16=__hip_bfloat16;
using bf16x8=__attribute__((ext_vector_type(8)))short;
using s16x4=__attribute__((ext_vector_type(4)))short;
using f32x16=__attribute__((ext_vector_type(16)))float;
using u32x4=__attribute__((ext_vector_type(4)))unsigned;
constexpr int BATCH=4,NHEAD=16,SEQ=4096,D=64,QP=512,KP=512,VP=512,OP=1024;
constexpr int NW=8,QBLK=32,QB=QBLK*NW,KVBLK=64,NQB=SEQ/QB;
constexpr int ATTN_UNIT_ROWS=QB;
__device__ __forceinline__ int crow(int r,int hi){return (r&3)+8*(r>>2)+4*hi;}
#define SBAR() __builtin_amdgcn_sched_barrier(0)
__device__ __forceinline__ void cmask(f32x16&p0,f32x16&p1,int jb,int qrel,int hi){
  const float NEG=-INFINITY; int kb=64*jb+4*hi;
  #pragma unroll
  for(int r=0;r<16;++r){int kv=kb+(r&3)+8*(r>>2); if(kv>qrel)p0[r]=NEG; if(kv+32>qrel)p1[r]=NEG;}
}

constexpr int NSLOT=3, SLOTB=8192;
constexpr int LDS_K=0, LDS_V=NSLOT*SLOTB, LDS_WS=2*NSLOT*SLOTB, LDS_OST=LDS_WS+NW*64*4, LDS_BYTES=LDS_OST+NW*4096;
constexpr float C2=0.125f*1.4426950408889634f;
__device__ __forceinline__ void glds16(const void*gsrc,unsigned lds_dst){unsigned keep;
  asm volatile("s_mov_b32 %0, m0\n\ts_mov_b32 m0, %2\n\ts_nop 0\n\tglobal_load_lds_dwordx4 %1, off\n\ts_mov_b32 m0, %0":"=&s"(keep):"v"(gsrc),"s"(lds_dst):"memory");}
__device__ __forceinline__ float max3f(float a,float b,float c){float r;asm("v_max3_f32 %0, %1, %2, %3":"=v"(r):"v"(a),"v"(b),"v"(c));return r;}
__device__ __forceinline__ float max2f(float a,float b){float r;asm("v_max_f32_e32 %0, %1, %2":"=v"(r):"v"(a),"v"(b));return r;}
__device__ __forceinline__ float fadd_s(float a,float b){float r;asm("v_add_f32_e32 %0, %1, %2":"=v"(r):"v"(a),"v"(b));return r;}
__device__ __forceinline__ float fsub_s(float a,float b){float r;asm("v_sub_f32_e32 %0, %1, %2":"=v"(r):"v"(a),"v"(b));return r;}
typedef float f32x2_t __attribute__((ext_vector_type(2))); typedef __bf16 bf16x2_t __attribute__((ext_vector_type(2)));
__device__ __forceinline__ unsigned cvtpk_s(float lo,float hi){f32x2_t v={lo,hi};bf16x2_t b=__builtin_convertvector(v,bf16x2_t);return __builtin_bit_cast(unsigned,b);}
#define WAIT_BAR(N) asm volatile("s_waitcnt vmcnt(" #N ") lgkmcnt(0)\n\ts_barrier":::"memory")

__device__ __forceinline__ void qkt(f32x16&p0,f32x16&p1,const char*Kslot,const bf16x8*qr,const f32x16&negm,int r32,int hi){
  const char*kb=Kslot+hi*1024+r32*16;
  #pragma unroll
  for(int d0=0;d0<4;++d0){
    const bf16x8 b0=*reinterpret_cast<const bf16x8*>(kb+d0*2048);
    const bf16x8 b1=*reinterpret_cast<const bf16x8*>(kb+d0*2048+512);
    if(d0==0){p0=__builtin_amdgcn_mfma_f32_32x32x16_bf16(b0,qr[0],negm,0,0,0);p1=__builtin_amdgcn_mfma_f32_32x32x16_bf16(b1,qr[0],negm,0,0,0);}
    else{p0=__builtin_amdgcn_mfma_f32_32x32x16_bf16(b0,qr[d0],p0,0,0,0);p1=__builtin_amdgcn_mfma_f32_32x32x16_bf16(b1,qr[d0],p1,0,0,0);}}
}
typedef __attribute__((address_space(3))) const char* lds_cptr;
typedef short v4i16_t __attribute__((ext_vector_type(4)));
__device__ __forceinline__ void kload8(bf16x8*kf,lds_cptr kp){
  kf[0]=*(const __attribute__((address_space(3))) bf16x8*)(kp);      kf[1]=*(const __attribute__((address_space(3))) bf16x8*)(kp+512);
  kf[2]=*(const __attribute__((address_space(3))) bf16x8*)(kp+2048); kf[3]=*(const __attribute__((address_space(3))) bf16x8*)(kp+2560);
  kf[4]=*(const __attribute__((address_space(3))) bf16x8*)(kp+4096); kf[5]=*(const __attribute__((address_space(3))) bf16x8*)(kp+4608);
  kf[6]=*(const __attribute__((address_space(3))) bf16x8*)(kp+6144); kf[7]=*(const __attribute__((address_space(3))) bf16x8*)(kp+6656);
}
__device__ __forceinline__ void kload2(bf16x8*kf,lds_cptr kp,int j){ kf[2*j]=*(const __attribute__((address_space(3))) bf16x8*)(kp+j*2048); kf[2*j+1]=*(const __attribute__((address_space(3))) bf16x8*)(kp+j*2048+512); }
__device__ __forceinline__ s16x4 vtr(lds_cptr p){ return __builtin_bit_cast(s16x4,__builtin_amdgcn_ds_read_tr16_b64_v4i16((__attribute__((address_space(3))) v4i16_t*)p)); }
__device__ __forceinline__ float rowmax(const f32x16&p0,const f32x16&p1){
  float a=max3f(p0[0],p0[1],p1[0]),b=max3f(p0[2],p0[3],p1[1]);a=max3f(a,p1[2],p1[3]);
  #pragma unroll
  for(int r=4;r<16;r+=4){a=max3f(a,p0[r],p0[r+1]);b=max3f(b,p0[r+2],p0[r+3]);a=max3f(a,p1[r],p1[r+1]);b=max3f(b,p1[r+2],p1[r+3]);}
  const float m=max2f(a,b);
  auto rr=__builtin_amdgcn_permlane32_swap(__float_as_uint(m),__float_as_uint(m),false,false);
  return max2f(__uint_as_float(rr[0]),__uint_as_float(rr[1]));
}
__device__ __forceinline__ void pv(f32x16*o,int vb,bf16x8 pa0,bf16x8 pa1,bf16x8 pa2,bf16x8 pa3){
  #pragma unroll
  for(int d0=0;d0<2;++d0){s16x4 lo[4],hi[4];
    #pragma unroll
    for(int ks=0;ks<4;++ks){
      asm volatile("ds_read_b64_tr_b16 %0,%1 offset:%c2":"=&v"(lo[ks]):"v"(vb),"i"(d0*4096+ks*1024):"memory");
      asm volatile("ds_read_b64_tr_b16 %0,%1 offset:%c2":"=&v"(hi[ks]):"v"(vb),"i"(d0*4096+ks*1024+512):"memory");}
    asm volatile("s_waitcnt lgkmcnt(0)":::"memory");SBAR();
    #define PK(k) (bf16x8){lo[k][0],lo[k][1],lo[k][2],lo[k][3],hi[k][0],hi[k][1],hi[k][2],hi[k][3]}
    o[d0]=__builtin_amdgcn_mfma_f32_32x32x16_bf16(pa0,PK(0),o[d0],0,0,0);
    o[d0]=__builtin_amdgcn_mfma_f32_32x32x16_bf16(pa1,PK(1),o[d0],0,0,0);
    o[d0]=__builtin_amdgcn_mfma_f32_32x32x16_bf16(pa2,PK(2),o[d0],0,0,0);
    o[d0]=__builtin_amdgcn_mfma_f32_32x32x16_bf16(pa3,PK(3),o[d0],0,0,0);
    #undef PK
  }
}

#ifndef ATTN_STORE16
#define ATTN_STORE16(p,v) (*(u32x4*)(p)=(v))
#endif
template<int THRL> __device__ __forceinline__ void attn_unit(int b,int h,int qb,const bf16*Q,const bf16*__restrict__ K,const bf16*__restrict__ V,bf16*O,char*shm){
  const int tid=opaque_tid(),lane=tid&63,r32=lane&31,hi=lane>>5; const int wid=__builtin_amdgcn_readfirstlane(tid>>6);
  const long rowbase=(long)b*SEQ; const int q0=qb*QB;
  const int h4=h>>2,hc=h>>1,vhalf=h&1; const bf16*Qw=Q+(rowbase+q0+wid*QBLK)*QP+hc*D;
  const bf16*Kh=K+rowbase*KP+hc*D,*Vh=V+rowbase*VP+h4*128+vhalf*D;
  const unsigned lds0=(unsigned)(uintptr_t)shm;
  float*wsf=(float*)(shm+LDS_WS)+wid*64;
  const bf16*ksrc=Kh+(long)lane*KP+wid*8;
  const bf16*vsrc=Vh+(long)(16*(wid&3)+(lane>>2))*VP+(wid>>2)*32+(lane&3)*8;
  const unsigned kdst=lds0+LDS_K+wid*1024, vdst=lds0+LDS_V+wid*1024;
  #define DMA_K(t,slot) glds16(ksrc+(long)(t)*KVBLK*KP,(unsigned)__builtin_amdgcn_readfirstlane(kdst+(slot)))
  #define DMA_V(t,slot) glds16(vsrc+(long)(t)*KVBLK*VP,(unsigned)__builtin_amdgcn_readfirstlane(vdst+(slot)))
  const int vb0=(int)(lds0+LDS_V)+((lane>>4)&1)*32+(lane&3)*8+(4*hi+((lane&15)>>2))*64;
  const char*Kbase=shm+LDS_K; bf16x8 kf[8];
  const lds_cptr shm3=(lds_cptr)shm; const lds_cptr kp0=shm3+LDS_K+hi*1024+r32*16; const lds_cptr vp0=shm3+LDS_V+((lane>>4)&1)*32+(lane&3)*8+(4*hi+((lane&15)>>2))*64;
  const int NT=(q0+QB)/KVBLK;
  DMA_K(0,0);DMA_V(0,0);DMA_K(1,SLOTB);
  bf16x8 qr[4];
  #pragma unroll
  for(int d0=0;d0<4;++d0)qr[d0]=*reinterpret_cast<const bf16x8*>(&Qw[(long)r32*QP+d0*16+hi*8]);
  float mhat=0.f,l_reg=0.f;f32x16 o[2];o[0]=f32x16{};o[1]=f32x16{};f32x16 negm=f32x16{};asm volatile("":"+v"(negm));
  const int qrel=wid*QBLK+r32;
  #define CMASK(P0,P1,t) do{int jb_=(t)-(NT-4); if(jb_>=0)cmask(P0,P1,jb_,qrel,hi);}while(0)
  bool resc=false;
  #define START(P0,P1) do{ const float rm=rowmax(P0,P1); resc=false; \
    { const float dl=rm; mhat=fadd_s(mhat,dl); \
      _Pragma("unroll") for(int r=0;r<16;++r){P0[r]=fsub_s(P0[r],dl);P1[r]=fsub_s(P1[r],dl);} \
      _Pragma("unroll") for(int r=0;r<16;++r)negm[r]=-mhat; asm volatile("":"+v"(negm)); } \
    _Pragma("unroll") for(int r=0;r<16;++r)P0[r]=__builtin_amdgcn_exp2f(P0[r]); }while(0)
  #define RESC() do{ if(resc){ asm volatile("s_waitcnt lgkmcnt(0)":::"memory"); \
      _Pragma("unroll") for(int d_=0;d_<2;++d_) _Pragma("unroll") for(int r=0;r<16;++r)o[d_][r]*=wsf[crow(r,hi)]; } }while(0)
  f32x16 pA0,pA1,pB0,pB1;
  int sl_prev=0,sl_cur=0,sl_next=SLOTB;
  #define ROT() do{sl_prev=sl_cur;sl_cur=sl_next;sl_next=(sl_next==(NSLOT-1)*SLOTB)?0:sl_next+SLOTB;}while(0)
  DMA_K(2,2*SLOTB);
  WAIT_BAR(3);
  qkt(pA0,pA1,Kbase,qr,negm,r32,hi);asm volatile("s_nop 15\n\ts_nop 7":"+v"(pA0),"+v"(pA1));CMASK(pA0,pA1,0);
  START(pA0,pA1);
  _Pragma("unroll") for(int r=0;r<16;++r)pA1[r]=__builtin_amdgcn_exp2f(pA1[r]);
  WAIT_BAR(0);
  DMA_K(3,0);DMA_V(1,SLOTB);
  ROT();
  kload8(kf,kp0+sl_cur);
  WAIT_BAR(2);
  s16x4 vlo[8],vhi[8]; u32x4 pw0,pw1,pw2,pw3;
  #define PKW(P,B) cvtpk_s(P[B],P[B+1])
  #define PAF(k) __builtin_bit_cast(bf16x8,pw##k)
  #define VFR(i) (bf16x8){vlo[i][0],vlo[i][1],vlo[i][2],vlo[i][3],vhi[i][0],vhi[i][1],vhi[i][2],vhi[i][3]}
  #define PIN(x) asm volatile("":"+v"(x))
  #define MX3(a,b,c) __builtin_fmaxf(__builtin_fmaxf((a),(b)),(c))
  #define GAPA(MF,A0,A1,A2,A3,W0,W1,PW) do{ MF; sacc+=A0; sacc+=A1; sacc+=A2; sacc+=A3; PIN(sacc); W0; W1; PIN(PW); SBAR(); }while(0)
  #define EX(v) __builtin_amdgcn_exp2f(v)
  #define GAPB(MF,X,B) do{ MF; X[B]=EX(X[B]); X[B+1]=EX(X[B+1]); X[B+2]=EX(X[B+2]); X[B+3]=EX(X[B+3]); PIN(X); SBAR(); }while(0)
  #define VRD(i) do{ vlo[i]=vtr(vp_+(((i)>>2)*4096+((i)&3)*1024)); vhi[i]=vtr(vp_+(((i)>>2)*4096+((i)&3)*1024+512)); }while(0)
  #define KRD(G,j) do{ if(G){ kload2(kf,kp0+sl_next,j); SBAR(); } }while(0)
  #define STEP(C0,C1,P0,P1,t,GK,GV,GL) do{ SBAR(); \
    const lds_cptr vp_=vp0+sl_prev; \
    VRD(0); SBAR(); float sacc=(P0[0]+P0[1]); \
    GAPA(C0=__builtin_amdgcn_mfma_f32_32x32x16_bf16(kf[0],qr[0],negm,0,0,0), P0[2],P0[3],P0[4],P0[5],     pw0[0]=PKW(P0,0), pw0[1]=PKW(P0,2), pw0); \
    VRD(4); SBAR(); GAPA(C1=__builtin_amdgcn_mfma_f32_32x32x16_bf16(kf[1],qr[0],negm,0,0,0), P0[6],P0[7],P0[8],P0[9],     pw0[2]=PKW(P0,4), pw0[3]=PKW(P0,6), pw0); \
    VRD(1); SBAR(); GAPA(C0=__builtin_amdgcn_mfma_f32_32x32x16_bf16(kf[2],qr[1],C0,0,0,0),   P0[10],P0[11],P0[12],P0[13], pw1[0]=PKW(P0,8), pw1[1]=PKW(P0,10), pw1); \
    VRD(5); SBAR(); GAPA(C1=__builtin_amdgcn_mfma_f32_32x32x16_bf16(kf[3],qr[1],C1,0,0,0),   P0[14],P0[15],P1[0],P1[1],   pw1[2]=PKW(P0,12),pw1[3]=PKW(P0,14), pw1); \
    VRD(2); SBAR(); GAPA(C0=__builtin_amdgcn_mfma_f32_32x32x16_bf16(kf[4],qr[2],C0,0,0,0),   P1[2],P1[3],P1[4],P1[5],     pw2[0]=PKW(P1,0), pw2[1]=PKW(P1,2), pw2); \
    VRD(6); SBAR(); GAPA(C1=__builtin_amdgcn_mfma_f32_32x32x16_bf16(kf[5],qr[2],C1,0,0,0),   P1[6],P1[7],P1[8],P1[9],     pw2[2]=PKW(P1,4), pw2[3]=PKW(P1,6), pw2); \
    VRD(3); SBAR(); GAPA(C0=__builtin_amdgcn_mfma_f32_32x32x16_bf16(kf[6],qr[3],C0,0,0,0),   P1[10],P1[11],P1[12],P1[13], pw3[0]=PKW(P1,8), pw3[1]=PKW(P1,10), pw3); \
    VRD(7); SBAR(); GAPA(C1=__builtin_amdgcn_mfma_f32_32x32x16_bf16(kf[7],qr[3],C1,0,0,0),   P1[14],P1[15],0.f,0.f,       pw3[2]=PKW(P1,12),pw3[3]=PKW(P1,14), pw3); \
    l_reg+=sacc; \
    if(GK){DMA_K((t)+3,sl_cur);} if(GV){DMA_V((t)+1,sl_next);} \
    CMASK(C0,C1,t); \
    { float a=MX3(C0[0],C0[1],C1[0]),b=MX3(C0[2],C0[3],C1[1]); a=MX3(a,C1[2],C1[3]); \
      _Pragma("unroll") for(int r=4;r<16;r+=4){a=MX3(a,C0[r],C0[r+1]);b=MX3(b,C0[r+2],C0[r+3]);a=MX3(a,C1[r],C1[r+1]);b=MX3(b,C1[r+2],C1[r+3]);} \
      float rm=__builtin_fmaxf(a,b); { auto rr=__builtin_amdgcn_permlane32_swap(__float_as_uint(rm),__float_as_uint(rm),false,false); rm=__builtin_fmaxf(__uint_as_float(rr[0]),__uint_as_float(rr[1])); } \
      resc=false; \
      if(__builtin_expect(__any(rm>(float)THRL),0)){ const float dl=__builtin_fmaxf(rm,0.f); mhat+=dl; \
        _Pragma("unroll") for(int r=0;r<16;++r){C0[r]-=dl;C1[r]-=dl;} \
        _Pragma("unroll") for(int r=0;r<16;++r)negm[r]=-mhat; asm volatile("":"+v"(negm)); \
        const float f=__builtin_amdgcn_exp2f(-dl); l_reg*=f; if(hi==0)wsf[r32]=f; resc=true; } } \
    SBAR(); \
    GAPB(o[0]=__builtin_amdgcn_mfma_f32_32x32x16_bf16(PAF(0),VFR(0),o[0],0,0,0), C0,0); \
    GAPB(o[1]=__builtin_amdgcn_mfma_f32_32x32x16_bf16(PAF(0),VFR(4),o[1],0,0,0), C0,4); \
    KRD(GL,0); GAPB(o[0]=__builtin_amdgcn_mfma_f32_32x32x16_bf16(PAF(1),VFR(1),o[0],0,0,0), C0,8); \
    KRD(GL,1); GAPB(o[1]=__builtin_amdgcn_mfma_f32_32x32x16_bf16(PAF(1),VFR(5),o[1],0,0,0), C0,12); \
    KRD(GL,2); GAPB(o[0]=__builtin_amdgcn_mfma_f32_32x32x16_bf16(PAF(2),VFR(2),o[0],0,0,0), C1,0); \
    KRD(GL,3); GAPB(o[1]=__builtin_amdgcn_mfma_f32_32x32x16_bf16(PAF(2),VFR(6),o[1],0,0,0), C1,4); \
    GAPB(o[0]=__builtin_amdgcn_mfma_f32_32x32x16_bf16(PAF(3),VFR(3),o[0],0,0,0), C1,8); \
    GAPB(o[1]=__builtin_amdgcn_mfma_f32_32x32x16_bf16(PAF(3),VFR(7),o[1],0,0,0), C1,12); \
    }while(0)
  int t=1;
  #undef CMASK
  #define CMASK(P0,P1,t) do{}while(0)
  for(;t+5<NT;t+=2){
    STEP(pB0,pB1,pA0,pA1,t,true,true,true);     WAIT_BAR(2); RESC(); ROT();
    STEP(pA0,pA1,pB0,pB1,t+1,true,true,true);   WAIT_BAR(2); RESC(); ROT();
  }
  #undef CMASK
  #define CMASK(P0,P1,t) do{int jb_=(t)-(NT-4); if(jb_>=0)cmask(P0,P1,jb_,qrel,hi);}while(0)
  #define ENDW(tt) do{ if((tt)+3<NT){WAIT_BAR(2);} else if((tt)+2<NT){WAIT_BAR(1);} else {WAIT_BAR(0);} }while(0)
  for(;t+1<NT;t+=2){
    STEP(pB0,pB1,pA0,pA1,t,(t+3<NT),(t+1<NT),(t+1<NT));       ENDW(t);   RESC(); ROT();
    STEP(pA0,pA1,pB0,pB1,t+1,(t+4<NT),(t+2<NT),(t+2<NT));     ENDW(t+1); RESC(); ROT();
  }
  STEP(pB0,pB1,pA0,pA1,NT-1,false,false,false); RESC();
  { float sacc=pB0[0]+pB0[1]; _Pragma("unroll") for(int r=2;r<16;++r)sacc+=pB0[r]; _Pragma("unroll") for(int r=0;r<16;++r)sacc+=pB1[r]; l_reg+=sacc;
    pw0=(u32x4){PKW(pB0,0),PKW(pB0,2),PKW(pB0,4),PKW(pB0,6)};pw1=(u32x4){PKW(pB0,8),PKW(pB0,10),PKW(pB0,12),PKW(pB0,14)};pw2=(u32x4){PKW(pB1,0),PKW(pB1,2),PKW(pB1,4),PKW(pB1,6)};pw3=(u32x4){PKW(pB1,8),PKW(pB1,10),PKW(pB1,12),PKW(pB1,14)};
    SBAR(); pv(o,vb0+sl_cur,PAF(0),PAF(1),PAF(2),PAF(3)); }
  #undef PKW
  #undef PAF
  #undef VFR
  #undef PIN
  #undef MX3
  #undef GAPA
  #undef GAPB
  #undef EX
  #undef VRD
  #undef KRD
  #undef STEP
  #undef ENDW
  {auto rr=__builtin_amdgcn_permlane32_swap(__float_as_uint(l_reg),__float_as_uint(l_reg),false,false);l_reg=__uint_as_float(rr[0])+__uint_as_float(rr[1]);}
  if(hi==0)wsf[32+r32]=l_reg;asm volatile("s_waitcnt lgkmcnt(0)":::"memory");
  float rli[16];
  #pragma unroll
  for(int r=0;r<16;++r)rli[r]=__builtin_amdgcn_rcpf(wsf[32+crow(r,hi)]);
  bf16*Ow=O+(rowbase+q0+wid*QBLK)*OP+h*D;
  { bf16*stg=(bf16*)(shm+LDS_OST)+wid*2048;
    #pragma unroll
    for(int r=0;r<16;++r){const int orow=crow(r,hi);
      #pragma unroll
      for(int d0=0;d0<2;++d0)stg[orow*64+d0*32+r32]=__float2bfloat16(o[d0][r]*rli[r]);}
    asm volatile("s_waitcnt lgkmcnt(0)":::"memory");
    #pragma unroll
    for(int i=0;i<4;++i){const int row=i*8+(lane>>3),ch=lane&7; const u32x4 v=*(const u32x4*)(stg+row*64+ch*8); ATTN_STORE16(Ow+(long)row*OP+ch*8,v);} }
  asm volatile("s_waitcnt lgkmcnt(0)\n\ts_barrier":::"memory");
  #undef DMA_K
  #undef DMA_V
  #undef CMASK
  #undef START
  #undef RESC
  #undef ROT
}
constexpr int ATTN_LDS_BYTES=LDS_BYTES;
struct AttnTensors { const bf16* Q; const bf16* K; const bf16* V; bf16* O; };
struct AttnUnit { int bh; int qb; };
struct StaticOrder {
  int vcu,G;
  __device__ __forceinline__ explicit StaticOrder(int grid,int block):vcu((grid%8==0)?(block%8)*(grid/8)+block/8:block),G(grid){}
  __device__ __forceinline__ bool next(int i,AttnUnit&u)const{
    if(G==256){ if(i>=4)return false; const int s=vcu&3; u.bh=vcu>>2; u.qb=(i==0)?s:(i==1)?7-s:(i==2)?8+s:15-s; return true; }
    const int L=i*G+vcu; if(L>=BATCH*NHEAD*NQB)return false; u.bh=L/NQB; u.qb=L%NQB; return true; }
  __device__ __forceinline__ void a_ready(const AttnUnit&)const{}
  __device__ __forceinline__ void done(const AttnUnit&)const{}
};
template<class Sched,int THRL=8> __device__ __forceinline__ void attn_phase(char*lds,const AttnTensors&T,const Sched&S){
  AttnUnit u;
  for(int i=0;S.next(i,u);++i){ S.a_ready(u); attn_unit<THRL>(u.bh/NHEAD,u.bh%NHEAD,u.qb,T.Q,T.K,T.V,T.O,lds); S.done(u); }
}
#undef SBAR
#undef WAIT_BAR
}

constexpr int CW_PANEL = 8192;
__device__ __forceinline__ void panel_barrier(unsigned* ctl, int stage, int pm) {
    asm volatile("s_waitcnt vmcnt(0)" ::: "memory");
    __syncthreads();
    if (opaque_tid() == 0) {
        unsigned* w = ctl + CW_PANEL + (stage * 64 + pm) * 64; unsigned* tmo = ctl + CW_BAR + XB_TMO;
        __builtin_amdgcn_fence(__ATOMIC_RELEASE, "agent");
        asm volatile("s_waitcnt vmcnt(0)" ::: "memory");
        (void)xb_add(w, 1u);
        unsigned sp = 0u;
        while (xb_ld(w) < 4u) { __builtin_amdgcn_s_sleep(1); if ((++sp & 255u) == 0u) { if (xb_ld(tmo)) break; if (sp > XB_SPIN_CAP) { atomicAdd(tmo, 1u); break; } } }
        __builtin_amdgcn_fence(__ATOMIC_ACQUIRE, "agent");
        asm volatile("s_waitcnt vmcnt(0)" ::: "memory");
    }
    __syncthreads();
}
namespace pg8 {
struct EpiGateFinal {
    static constexpr bool PERM = true, AFTER_DRAIN = true;
    float* out; const bf16_t* h2b; const bf16_t* pp; float cs; const float* ln_f; float* xs  ; unsigned* ctl;
    __device__ __forceinline__ void fused(f32x4 (&acc)[2][2][4][2], const Unit& u, int wr, int wc, int fr, int fq, PG8_LAS unsigned char* lds, int wid, int lane) const {
        PG8_LAS float* P = (PG8_LAS float*)lds;
        PG8_LAS float* S = (PG8_LAS float*)(lds + 4096);
        const int row0 = u.pm * BM + wr * 64 + fr, col0 = u.pn * BM + wc * 32 + 8 * fq;
#pragma unroll
        for (int ai = 0; ai < 2; ++ai)
#pragma unroll
            for (int m = 0; m < 4; ++m) { const int row = row0 + ai * HALF + m * 16; const float rs = cs; const size_t off = (size_t)row * 1024 + col0; float ssq = 0.f;
#pragma unroll
                for (int bj = 0; bj < 2; ++bj) { f32x4 g0, g1, q0, q1; unpack8(*(const u32x4*)(pp + off + bj * HALF), g0, g1); unpack8(*(const u32x4*)(h2b + off + bj * HALF), q0, q1);
                    const f32x4 a = q0 + sig4(acc[ai][bj][m][0] * rs) * g0, b = q1 + sig4(acc[ai][bj][m][1] * rs) * g1; acc[ai][bj][m][0] = a; acc[ai][bj][m][1] = b;
                    ssq += (a[0] * a[0] + a[1] * a[1]) + (a[2] * a[2] + a[3] * a[3]) + (b[0] * b[0] + b[1] * b[1]) + (b[2] * b[2] + b[3] * b[3]); }
                asm volatile("" : "+v"(acc[ai][0][m][0]), "+v"(acc[ai][0][m][1]), "+v"(acc[ai][1][m][0]), "+v"(acc[ai][1][m][1]));
                ssq += __shfl_xor(ssq, 16); ssq += __shfl_xor(ssq, 32);
                if (fq == 0) P[(ai * HALF + wr * 64 + m * 16 + fr) * 4 + wc] = ssq; }
        asm volatile("s_waitcnt lgkmcnt(0)" ::: "memory"); __builtin_amdgcn_s_barrier(); asm volatile("" ::: "memory");
        const int tid = wid * 64 + lane;
        if (tid < 256) xs[((size_t)u.pm * 256 + tid) * 4 + u.pn] = (P[tid * 4 + 0] + P[tid * 4 + 1]) + (P[tid * 4 + 2] + P[tid * 4 + 3]);
        panel_barrier(ctl, 3, u.pm);
        if (tid < 256) { const f32x4 t = *(const f32x4*)(xs + ((size_t)u.pm * 256 + tid) * 4); S[tid] = rsqrtf(((t[0] + t[1]) + (t[2] + t[3])) * (1.f / 1024.f) + 1e-6f); }
        asm volatile("s_waitcnt lgkmcnt(0)" ::: "memory"); __builtin_amdgcn_s_barrier(); asm volatile("" ::: "memory");
        f32x4 lf[2][2];
#pragma unroll
        for (int bj = 0; bj < 2; ++bj) { lf[bj][0] = *(const f32x4*)(ln_f + col0 + bj * HALF); lf[bj][1] = *(const f32x4*)(ln_f + col0 + bj * HALF + 4); }
#pragma unroll
        for (int ai = 0; ai < 2; ++ai)
#pragma unroll
            for (int m = 0; m < 4; ++m) { const int rl = ai * HALF + wr * 64 + m * 16 + fr; const float rstd = S[rl]; float* o = out + (size_t)(u.pm * BM + rl) * 1024 + col0;
#pragma unroll
                for (int bj = 0; bj < 2; ++bj) { *(f32x4*)(o + bj * HALF) = acc[ai][bj][m][0] * rstd * lf[bj][0]; *(f32x4*)(o + bj * HALF + 4) = acc[ai][bj][m][1] * rstd * lf[bj][1]; } }
    }
};
}
namespace pg8 {
struct PanelOrder { int v; __device__ __forceinline__ bool next(int i, Unit& u) const { if (i > 0) return false; u.pm = v >> 2; u.pn = v & 3; return true; }
    __device__ __forceinline__ void a_ready(const Unit&) const {} __device__ __forceinline__ void done(const Unit&) const {} };
}
struct Args { const void* in[32]; float* out; unsigned char* ws; int ph_lo, ph_hi; };
struct Ctx {
    unsigned char* lds;
    int tid, lane, wave, bid, G, vcu;
    const float *x, *p; const int* positions;
    const float *ln_mix, *w_in, *conv_w, *conv_b, *w_a, *b_a, *w_i, *b_i, *rg_lambda, *g_rec, *lq1, *lk1, *lq2, *lk2, *g_sub, *w_out, *ln_moe, *w_router, *e_bias, *w1, *w3, *w2, *ws1, *ws3, *ws2, *ln_ple, *w_pg, *w_pp, *ln_f;
    float* out; unsigned char* ws;
    unsigned* ctl; float *rstd1, *rstd2, *rope, *sum, *topw; bf16* WrT; bf16* WgT; int* ident; unsigned* lau; float* rx; unsigned* topd; int* rowtok;
    unsigned char *W13F8, *H1F8, *W2F8, *ACT8, *H2F8; bf16 *H3B, *WoutT, *WpgT, *WppT, *WinT, *W2T, *W13T, *XB, *MIX, *ZA, *H1B, *Q, *K, *V, *O, *ACT, *H2B, *PB, *Gt; unsigned char* YB;
};

__device__ __forceinline__ unsigned cvtpk(float lo, float hi) { unsigned r; asm volatile("v_cvt_pk_bf16_f32 %0, %1, %2" : "=v"(r) : "v"(lo), "v"(hi)); return r; }
__device__ __forceinline__ void p0_item(const float* W, int K, int N, const float* gain, bf16* WT, int rowmode, int sel, float* scr, int item, int lane) {
    const int nblk = N / 64, kb = item / nblk, nb = item % nblk, k0 = 64 * kb, n0 = 64 * nb;
    const float* wp = W + (size_t)k0 * N + n0 + lane;
    { float v[64];
#pragma unroll
        for (int i = 0; i < 64; ++i) v[i] = wp[(size_t)i * N];
#pragma unroll
        for (int i = 0; i < 64; ++i) scr[i * 64 + (lane ^ i)] = v[i] * (gain ? gain[k0 + i] : 1.f); }
    LDS_WAIT();
    const int c = lane & 7, nl = lane >> 3;
#pragma unroll
    for (int jj = 0; jj < 8; ++jj) { const int n = nl + 8 * jj; const int nn = n0 + n; const int row = rowmode ? ((nn >> 7) * 256 + sel * 128 + (nn & 127)) : nn;
        float f[8];
#pragma unroll
        for (int j = 0; j < 8; ++j) { const int kk = 8 * c + j; f[j] = scr[kk * 64 + (n ^ kk)]; }
        u32x4 o; o.x = cvtpk(f[0], f[1]); o.y = cvtpk(f[2], f[3]); o.z = cvtpk(f[4], f[5]); o.w = cvtpk(f[6], f[7]);
        *(u32x4*)(WT + (size_t)row * K + k0 + 8 * c) = o; }
    LDS_WAIT();
}
__device__ __forceinline__ void p0_item_f8(const float* W, int K, int N, const float* gain, float scale, unsigned char* WT8, int rowmode, int sel, float* scr, int item, int lane) {
    asm volatile("" : "+v"(lane));
    const int nblk = N / 64, kb = item / nblk, nb = item % nblk, k0 = 64 * kb, n0 = 64 * nb;
    const float* wp = W + (size_t)k0 * N + n0 + lane;
    { float v[64];
#pragma unroll
        for (int i = 0; i < 64; ++i) v[i] = wp[(size_t)i * N];
#pragma unroll
        for (int i = 0; i < 64; ++i) scr[i * 64 + (lane ^ i)] = v[i] * (gain ? gain[k0 + i] : 1.f) * scale; }
    LDS_WAIT();
    const int c = lane & 3, nl = lane >> 2;
#pragma unroll 1
    for (int jj = 0; jj < 4; ++jj) { const int n = nl + 16 * jj; const int nn = n0 + n; const int row = rowmode ? ((nn >> 7) * 256 + sel * 128 + (nn & 127)) : nn;
        float f[16];
#pragma unroll
        for (int j = 0; j < 16; ++j) { const int kk = 16 * c + j; f[j] = scr[kk * 64 + (n ^ kk)]; }
        u32x4 o;
#pragma unroll
        for (int d = 0; d < 4; ++d) { int w = __builtin_amdgcn_cvt_pk_fp8_f32(f[4 * d], f[4 * d + 1], 0, false); w = __builtin_amdgcn_cvt_pk_fp8_f32(f[4 * d + 2], f[4 * d + 3], w, true); o[d] = (unsigned)w; }
        *(u32x4*)(WT8 + (size_t)row * K + k0 + 16 * c) = o; }
    LDS_WAIT();
}
__device__ __forceinline__ void phase_prologue(Ctx& F) {
    float* scr = (float*)(F.lds + F.wave * 16384);
    const int gw = F.bid * NWAVES + F.wave, NGW = F.G * NWAVES;
    constexpr int I_IN = 16 * 40, I_SQ = 16 * 16, I_PP = 4 * 16, I_E = 64;
    constexpr int N0 = I_IN, N1 = N0 + I_SQ, N2 = N1 + I_SQ, N3 = N2 + I_PP, N4 = N3 + 64 * I_E, N5 = N4 + 64 * I_E, N6 = N5 + I_E, N7 = N6 + I_E, N8 = N7 + 64 * I_E, N9 = N8 + I_E, N10 = N9 + 16, N11 = N10 + 16;
    for (int it = gw; it < N11; it += NGW) {
        const float* W; const float* gain = nullptr; bf16* WT; int K = D, N = D, rowmode = 0, sel = 0, item = it; bool f8 = false;
        if (it < N0) { W = F.w_in; N = DIN; gain = F.ln_mix; WT = F.WinT; }
        else if (it < N1) { W = F.w_out; WT = F.WoutT; item = it - N0; }
        else if (it < N2) { W = F.w_pg; gain = F.ln_ple; WT = F.WpgT; item = it - N1; f8 = true; }
        else if (it < N3) { W = F.w_pp; K = DPLE; WT = F.WppT; item = it - N2; }
        else if (it < N4) { const int r = it - N3, e = r / I_E; W = F.w1 + (size_t)e * D * FE; N = FE; gain = F.ln_moe; WT = (bf16*)(F.W13F8 + (size_t)e * 512 * D); rowmode = 1; item = r % I_E; }
        else if (it < N5) { const int r = it - N4, e = r / I_E; W = F.w3 + (size_t)e * D * FE; N = FE; gain = F.ln_moe; WT = (bf16*)(F.W13F8 + (size_t)e * 512 * D); rowmode = 1; sel = 1; item = r % I_E; }
        else if (it < N6) { W = F.ws1; N = FE; gain = F.ln_moe; WT = (bf16*)(F.W13F8 + (size_t)NE * 512 * D); rowmode = 1; item = it - N5; }
        else if (it < N7) { W = F.ws3; N = FE; gain = F.ln_moe; WT = (bf16*)(F.W13F8 + (size_t)NE * 512 * D); rowmode = 1; sel = 1; item = it - N6; }
        else if (it < N9) { if (F.G == 256) continue;
            if (it < N8) { const int r = it - N7, e = r / I_E; W = F.w2 + (size_t)e * FE * D; K = FE; WT = (bf16*)(F.W2F8 + (size_t)e * D * FE); item = r % I_E; }
            else { W = F.ws2; K = FE; WT = (bf16*)(F.W2F8 + (size_t)NE * D * FE); item = it - N8; }
            p0_item_f8(W, K, N, nullptr, W2SCALE, (unsigned char*)WT, 0, 0, scr, item, F.lane); continue; }
        else if (it < N10) { W = F.w_router; N = NE; gain = F.ln_moe; WT = F.WrT; item = it - N9; }
        else { const int r = it - N10, m = r >> 3, g = r & 7; W = (m ? F.w_i : F.w_a) + (size_t)g * 4096; K = 64; N = 64; WT = F.WgT + (size_t)(m * 8 + g) * 4096; item = 0; }
        if (rowmode || f8) p0_item_f8(W, K, N, gain, rowmode ? W13SCALE : WPGSCALE, (unsigned char*)WT, rowmode, sel, scr, item, F.lane);
        else p0_item(W, K, N, gain, WT, rowmode, sel, scr, item, F.lane);
    }
    { typedef float f32x4_t __attribute__((ext_vector_type(4))); typedef unsigned u32x2_t __attribute__((ext_vector_type(2)));
      for (int rb = gw * 4; rb < T; rb += NGW * 4) {
        f32x4_t v[4][4];
#pragma unroll
        for (int r = 0; r < 4; ++r) { const f32x4_t* xr = (const f32x4_t*)(F.x + (size_t)(rb + r) * D) + F.lane;
#pragma unroll
            for (int j = 0; j < 4; ++j) v[r][j] = xr[64 * j]; }
#pragma unroll
        for (int r = 0; r < 4; ++r) { float s = 0.f;
#pragma unroll
            for (int j = 0; j < 4; ++j) s += v[r][j][0] * v[r][j][0] + v[r][j][1] * v[r][j][1] + v[r][j][2] * v[r][j][2] + v[r][j][3] * v[r][j][3];
            const float rstd = rsqrtf(wave_sum(s) * (1.f / D) + EPS); if (F.lane == 0) F.rx[rb + r] = 1.f / rstd;
            u32x2_t* o = (u32x2_t*)(F.XB + (size_t)(rb + r) * D) + F.lane;
#pragma unroll
            for (int j = 0; j < 4; ++j) o[64 * j] = (u32x2_t){cvtpk(v[r][j][0] * rstd, v[r][j][1] * rstd), cvtpk(v[r][j][2] * rstd, v[r][j][3] * rstd)}; }
      } }
    for (int i = F.bid * NTHR + F.tid; i < T; i += F.G * NTHR) F.ident[i] = i;
    for (int i = F.bid * NTHR + F.tid; i < T * 8; i += F.G * NTHR) {
        const int t = i >> 3, f = i & 7; const float inv = powf(500000.f, -(float)f / 8.f); const float ang = (float)F.positions[t] * inv;
        F.rope[t * 16 + f] = cosf(ang); F.rope[t * 16 + 8 + f] = sinf(ang);
    }
}

__device__ __forceinline__ void phase_gemm1(Ctx& F) {
    pg8::Gemm g{F.XB, F.WinT, T, DIN, D}; pg8::StaticOrder S; S.init(T, DIN, F.G, F.bid);
    pg8::EpiG1 E{F.ZA, F.Q, F.K, F.V, F.rope};
    pg8::gemm_phase<pg8::EpiG1, pg8::StaticOrder, true, true>((LAS unsigned char*)F.lds, g, S, E);
    if (F.G == 256 && F.bid >= 128) {
        float* scr = (float*)(F.lds + F.wave * 16384);
        const int w = (F.bid - 128) * NWAVES + F.wave;
        for (int it = w; it < 65 * 64; it += 128 * NWAVES) { const int e = it >> 6;
            p0_item_f8(e < NE ? F.w2 + (size_t)e * FE * D : F.ws2, FE, D, nullptr, W2SCALE, F.W2F8 + (size_t)e * D * FE, 0, 0, scr, it & 63, F.lane); }
    }
}
constexpr int LDS_SX = 132096, LDS_SPART = 134144;
typedef short rb8 __attribute__((ext_vector_type(8))); typedef float rf4 __attribute__((ext_vector_type(4)));
__device__ __forceinline__ void rglru_pass0_mfma(Ctx& F, int unit, unsigned char* lds) {
    typedef float f32x4_t __attribute__((ext_vector_type(4)));
    const int b = unit / NCHUNK, c = unit % NCHUNK, g = F.wave, l = F.lane, tl = l & 15, q = l >> 4;
    LAS float* xct = (LAS float*)(lds + F.wave * 8192);
    LAS unsigned* lt = (LAS unsigned*)(lds + F.wave * 8192 + 4096);
    const size_t row0 = (size_t)b * SEQ + (size_t)c * CHUNK;
    rb8 Ba[4][2], Bi[4][2];
#pragma unroll
    for (int nt = 0; nt < 4; ++nt)
#pragma unroll
        for (int ks = 0; ks < 2; ++ks) { const size_t o = (size_t)(nt * 16 + tl) * 64 + ks * 32 + q * 8;
            Ba[nt][ks] = *(const rb8*)(F.WgT + (size_t)g * 4096 + o); Bi[nt][ks] = *(const rb8*)(F.WgT + (size_t)(8 + g) * 4096 + o); }
    float cba[4], cbi[4], csp[4];
#pragma unroll
    for (int nt = 0; nt < 4; ++nt) { const int chn = g * 64 + nt * 16 + tl; cba[nt] = F.b_a[chn]; cbi[nt] = F.b_i[chn]; csp[nt] = -8.f * log1pf(expf(-F.rg_lambda[chn])); }
    const int ch = g * 64 + l;
    float h = 0.f, ap = 1.f;
    for (int mt = 0; mt < 4; ++mt) {
        rb8 A[2];
        const int t = mt * 16 + tl;
#pragma unroll
        for (int ks = 0; ks < 2; ++ks) { const int c0 = g * 64 + ks * 32 + q * 8;
            f32x4_t x0 = *(const f32x4_t*)(F.conv_b + c0), x1 = *(const f32x4_t*)(F.conv_b + c0 + 4);
#pragma unroll
            for (int k = 0; k < 4; ++k) { const f32x4_t w0 = *(const f32x4_t*)(F.conv_w + k * 512 + c0), w1 = *(const f32x4_t*)(F.conv_w + k * 512 + c0 + 4);
                u32x4 xv = (u32x4){0u, 0u, 0u, 0u}; if (c > 0 || t + k >= 3) xv = *(const u32x4*)(F.ZA + (size_t)((long)row0 + t + k - 3) * 1024 + c0);
                x0[0] += w0[0] * __uint_as_float(xv.x << 16); x0[1] += w0[1] * __uint_as_float(xv.x & 0xffff0000u); x0[2] += w0[2] * __uint_as_float(xv.y << 16); x0[3] += w0[3] * __uint_as_float(xv.y & 0xffff0000u);
                x1[0] += w1[0] * __uint_as_float(xv.z << 16); x1[1] += w1[1] * __uint_as_float(xv.z & 0xffff0000u); x1[2] += w1[2] * __uint_as_float(xv.w << 16); x1[3] += w1[3] * __uint_as_float(xv.w & 0xffff0000u); }
            u32x4 pkd; pkd.x = cvtpk(x0[0], x0[1]); pkd.y = cvtpk(x0[2], x0[3]); pkd.z = cvtpk(x1[0], x1[1]); pkd.w = cvtpk(x1[2], x1[3]);
            A[ks] = __builtin_bit_cast(rb8, pkd);
            *(LAS f32x4_t*)(xct + tl * 64 + ks * 32 + q * 8) = x0; *(LAS f32x4_t*)(xct + tl * 64 + ks * 32 + q * 8 + 4) = x1; }
        LDS_WAIT();
#pragma unroll
        for (int nt = 0; nt < 4; ++nt) {
            rf4 ca = {0.f, 0.f, 0.f, 0.f}, ci = ca;
            ca = __builtin_amdgcn_mfma_f32_16x16x32_bf16(A[0], Ba[nt][0], ca, 0, 0, 0); ca = __builtin_amdgcn_mfma_f32_16x16x32_bf16(A[1], Ba[nt][1], ca, 0, 0, 0);
            ci = __builtin_amdgcn_mfma_f32_16x16x32_bf16(A[0], Bi[nt][0], ci, 0, 0, 0); ci = __builtin_amdgcn_mfma_f32_16x16x32_bf16(A[1], Bi[nt][1], ci, 0, 0, 0);
#pragma unroll
            for (int r = 0; r < 4; ++r) { const float rr = sigmoidf_(ca[r] + cba[nt]), ig = sigmoidf_(ci[r] + cbi[nt]);
                const float log_a = rr * csp[nt]; const float a = __expf(log_a); const float mult = __builtin_amdgcn_sqrtf(fmaxf(fmaf(-a, a, 1.f), 0.f));
                const float xc = xct[(4 * q + r) * 64 + nt * 16 + tl];
                lt[(4 * q + r) * 64 + nt * 16 + tl] = pk2(log_a, mult * ig * xc); }
        }
        LDS_WAIT();
#pragma unroll
        for (int tt = 0; tt < 16; ++tt) { const unsigned pk = lt[tt * 64 + l];
            F.lau[(row0 + mt * 16 + tt) * 512 + ch] = pk;
            const float ar = __expf(__uint_as_float(pk << 16)), ur = __uint_as_float(pk & 0xffff0000u);
            h = ar * h + ur; ap *= ar; }
        LDS_WAIT();
    }
    float* o = F.sum + ((size_t)(b * NCHUNK + c) * 512 + ch) * 2; o[0] = ap; o[1] = h;
}
__device__ __forceinline__ void rglru_pass1(Ctx& F, int unit) {
    const int b = unit / NCHUNK, c = unit % NCHUNK, g = F.wave, j = F.lane, ch = g * 64 + j;
    float* spart = (float*)(F.lds + LDS_SPART);
    float* ybuf = (float*)(F.lds + F.wave * 16384);
    const size_t row0 = (size_t)b * SEQ + (size_t)c * CHUNK;
    float h = 0.f;
    {
        typedef float f32x2_t __attribute__((ext_vector_type(2)));
        const f32x2_t* sp2 = (const f32x2_t*)F.sum + (size_t)(b * NCHUNK) * 512 + ch;
        { f32x2_t sv[NCHUNK - 1];
#pragma unroll
            for (int i = 0; i < NCHUNK - 1; ++i) sv[i] = (i < c) ? sp2[(size_t)i * 512] : (f32x2_t){1.f, 0.f};
#pragma unroll
            for (int i = 0; i < NCHUNK - 1; ++i) h = sv[i][0] * h + sv[i][1]; }
    }
    for (int t0 = 0; t0 < CHUNK; t0 += 16) { unsigned pk[16]; bf16 gt[16];
#pragma unroll
        for (int i = 0; i < 16; ++i) { pk[i] = F.lau[(row0 + t0 + i) * 512 + ch]; gt[i] = F.ZA[(row0 + t0 + i) * 1024 + 512 + ch]; }
#pragma unroll
        for (int i = 0; i < 16; ++i) { h = __expf(__uint_as_float(pk[i] << 16)) * h + __uint_as_float(pk[i] & 0xffff0000u);
            ybuf[(t0 + i) * 64 + (j ^ (t0 + i))] = h * gelu_tanh(bf2f(gt[i])); } }
    LDS_WAIT();
    { float s = 0.f;
#pragma unroll 16
        for (int cc = 0; cc < 64; ++cc) { const float v = ybuf[j * 64 + (cc ^ j)]; s += v * v; }
        spart[j * 8 + g] = s; }
    __syncthreads();
    const float gr = F.g_rec[ch];
    for (int t = 0; t < CHUNK; ++t) { float s = 0.f;
#pragma unroll
        for (int q = 0; q < 8; ++q) s += spart[t * 8 + q];
        F.MIX[(row0 + t) * 1024 + ch] = f2bf(ybuf[t * 64 + (j ^ t)] * rsqrtf(s * (1.f / 512.f) + EPS) * gr); }
    __syncthreads();
}

__device__ __forceinline__ void attmix_row(Ctx& F, int row) {
    const int lane = F.lane;
    const float s1 = wave_sum(F.lq1[lane] * F.lk1[lane]), s2 = wave_sum(F.lq2[lane] * F.lk2[lane]);
    const float lam = expf(s1) - expf(s2) + LAM_INIT;
    const bf16* op = F.O + (size_t)row * 1024;
    const int h = lane >> 4, e0 = (lane & 15) * 8, vhalf = e0 >> 6, d0 = e0 & 63;
    pg8::f32x4 a0, a1, b0, b1; pg8::unpack8(*(const u32x4*)(op + (h * 4 + 0 + vhalf) * 64 + d0), a0, a1); pg8::unpack8(*(const u32x4*)(op + (h * 4 + 2 + vhalf) * 64 + d0), b0, b1);
    pg8::f32x4 y0 = a0 - b0 * lam, y1 = a1 - b1 * lam;
    float s = (y0[0] * y0[0] + y0[1] * y0[1]) + (y0[2] * y0[2] + y0[3] * y0[3]) + (y1[0] * y1[0] + y1[1] * y1[1]) + (y1[2] * y1[2] + y1[3] * y1[3]);
    s += __shfl_xor(s, 1); s += __shfl_xor(s, 2); s += __shfl_xor(s, 4); s += __shfl_xor(s, 8);
    const float sc = rsqrtf(s * (1.f / 128.f) + EPS) * (1.f - LAM_INIT);
    const pg8::f32x4 g0 = *(const pg8::f32x4*)(F.g_sub + e0), g1 = *(const pg8::f32x4*)(F.g_sub + e0 + 4);
    *(u32x4*)(F.MIX + (size_t)row * 1024 + 512 + h * 128 + e0) = pg8::pack8(y0 * sc * g0, y1 * sc * g1);
}

__device__ __forceinline__ void phase_wout(Ctx& F) {
    pg8::Gemm g{F.MIX, F.WoutT, T, D, D}; pg8::EpiOutF E{F.XB, F.rx, F.H1B};
    if (F.G == 256) { pg8::PanelOrder S{F.vcu}; pg8::gemm_phase<pg8::EpiOutF, pg8::PanelOrder, true, true>((LAS unsigned char*)F.lds, g, S, E); }
    else { pg8::StaticOrder S; S.init(T, D, F.G, F.bid); pg8::gemm_phase<pg8::EpiOutF, pg8::StaticOrder, true, true>((LAS unsigned char*)F.lds, g, S, E); }
}

__device__ __forceinline__ float wave_sum_dpp(float v) {
#define WSD(ctrl) v += __uint_as_float((unsigned)__builtin_amdgcn_mov_dpp((int)__float_as_uint(v), ctrl, 0xF, 0xF, false))
    WSD(0xB1); WSD(0x4E); WSD(0x141); WSD(0x140);
#undef WSD
    const unsigned u = __float_as_uint(v);
    return (__uint_as_float(__builtin_amdgcn_readlane(u, 0)) + __uint_as_float(__builtin_amdgcn_readlane(u, 16))) + (__uint_as_float(__builtin_amdgcn_readlane(u, 32)) + __uint_as_float(__builtin_amdgcn_readlane(u, 48)));
}
__device__ __forceinline__ float bcast_lane(float v, int l) { return __uint_as_float(__builtin_amdgcn_readlane(__float_as_uint(v), l)); }
template <bool DRY>
__device__ __forceinline__ void router_block(Ctx& F, int tb, unsigned char* lds) {
    unsigned* cntp = DRY ? F.ctl + 2048 : F.ctl; int* rtk = DRY ? (int*)F.PB : F.rowtok; float* tw = DRY ? (float*)((unsigned char*)F.PB + 4 * MiB) : F.topw; unsigned* td = DRY ? (unsigned*)((unsigned char*)F.PB + 5 * MiB) : F.topd;
    LAS float* lg = (LAS float*)lds;
    LAS float* rsl = (LAS float*)(lds + LDS_SX);
    LAS unsigned* lcnt = (LAS unsigned*)(lds + LDS_SPART);
    const int e = F.lane;
    __syncthreads();
    if (F.tid < 64) lcnt[F.tid] = 0u;
    {
        const int r = e & 15, q = e >> 4, w = F.wave;
        const bf16* ap = F.H1B + (size_t)(tb * 64 + r) * D + w * 128 + q * 8; const bf16* bp = F.WrT + (size_t)r * D + w * 128 + q * 8;
        rf4 c[4][4]; float ss[4];
#pragma unroll
        for (int mt = 0; mt < 4; ++mt) { ss[mt] = 0.f;
#pragma unroll
            for (int nt = 0; nt < 4; ++nt) c[mt][nt] = (rf4){0.f, 0.f, 0.f, 0.f}; }
        u32x4 au[4][4]; rb8 bb[4][4];
#pragma unroll
        for (int ks = 0; ks < 4; ++ks)
#pragma unroll
            for (int i = 0; i < 4; ++i) { au[ks][i] = *(const u32x4*)(ap + (size_t)i * 16 * D + ks * 32); bb[ks][i] = *(const rb8*)(bp + (size_t)i * 16 * D + ks * 32); }
#pragma unroll
        for (int ks = 0; ks < 4; ++ks)
#pragma unroll
            for (int mt = 0; mt < 4; ++mt) { const u32x4 av = au[ks][mt]; const rb8 a = __builtin_bit_cast(rb8, av);
#pragma unroll
                for (int i = 0; i < 4; ++i) { const float lo = __uint_as_float(av[i] << 16), hi = __uint_as_float(av[i] & 0xffff0000u); ss[mt] += lo * lo + hi * hi; }
#pragma unroll
                for (int nt = 0; nt < 4; ++nt) c[mt][nt] = __builtin_amdgcn_mfma_f32_16x16x32_bf16(a, bb[ks][nt], c[mt][nt], 0, 0, 0); }
#pragma unroll
        for (int mt = 0; mt < 4; ++mt) { float sq = ss[mt]; sq += __shfl_xor(sq, 16); sq += __shfl_xor(sq, 32); if (q == 0) rsl[w * 64 + mt * 16 + r] = sq;
#pragma unroll
            for (int j = 0; j < 4; ++j) { LAS float* row = lg + w * 4096 + (mt * 16 + 4 * q + j) * 64 + r;
#pragma unroll
                for (int nt = 0; nt < 4; ++nt) row[nt * 16] = c[mt][nt][j]; } }
    }
    __syncthreads();
    const int t0 = tb * 64 + F.wave * 8;
    float acc[8], rstd[8];
#pragma unroll
    for (int t = 0; t < 8; ++t) { const int tl = F.wave * 8 + t; float a = 0.f, sq = 0.f;
#pragma unroll
        for (int w = 0; w < 8; ++w) { a += lg[w * 4096 + tl * 64 + e]; sq += rsl[w * 64 + tl]; }
        acc[t] = a; rstd[t] = rsqrtf(sq * (1.f / D) + EPS); }
    if (e < 8) { float rv = rstd[0];
#pragma unroll
        for (int t = 1; t < 8; ++t) rv = (e == t) ? rstd[t] : rv;
        F.rstd1[t0 + e] = rv; }
    const float bias = F.e_bias[e];
    unsigned selbits = 0u, slots = 0u; float wt[8]; int cntsel = 0;
#pragma unroll
    for (int t = 0; t < 8; ++t) {
        const float sc = __builtin_amdgcn_rcpf(1.f + __expf(-acc[t] * rstd[t])); const float sel = sc + bias;
#define G8F(v) __uint_as_float((unsigned)__builtin_amdgcn_mov_dpp((int)__float_as_uint(v), 0xB1, 0xF, 0xF, false))
#define G8G(v) __uint_as_float((unsigned)__builtin_amdgcn_mov_dpp((int)__float_as_uint(v), 0x4E, 0xF, 0xF, false))
#define G8H(v) __uint_as_float((unsigned)__builtin_amdgcn_mov_dpp((int)__float_as_uint(v), 0x141, 0xF, 0xF, false))
        float m1 = sel; m1 = fmaxf(m1, G8F(m1)); m1 = fmaxf(m1, G8G(m1)); m1 = fmaxf(m1, G8H(m1));
        int fl = (sel == m1) ? e : 64; fl = min(fl, __builtin_amdgcn_mov_dpp(fl, 0xB1, 0xF, 0xF, false)); fl = min(fl, __builtin_amdgcn_mov_dpp(fl, 0x4E, 0xF, 0xF, false)); fl = min(fl, __builtin_amdgcn_mov_dpp(fl, 0x141, 0xF, 0xF, false));
        float m2 = (e == fl) ? -INFINITY : sel; m2 = fmaxf(m2, G8F(m2)); m2 = fmaxf(m2, G8G(m2)); m2 = fmaxf(m2, G8H(m2));
#undef G8F
#undef G8G
#undef G8H
        const float gs = m1 + m2; const int g = e >> 3;
        int grank = 0;
#pragma unroll
        for (int gg = 0; gg < 8; ++gg) { const float o = bcast_lane(gs, gg * 8); grank += (o > gs || (o == gs && gg < g)) ? 1 : 0; }
        const bool elig = grank < 4; const float ms = elig ? sel : -INFINITY;
        unsigned kb = __float_as_uint(ms); kb = (kb & 0x80000000u) ? ~kb : (kb | 0x80000000u); const unsigned key = elig ? kb : 0u;
        unsigned thr = 0u;
#pragma unroll
        for (int b = 31; b >= 0; --b) { const unsigned cand = thr | (1u << b); thr = (__popcll(__ballot(key >= cand)) >= 8) ? cand : thr; }
        const unsigned long long mgt = __ballot(key > thr), meq = __ballot(key == thr);
        const int need = 8 - __popcll(mgt);
        const int eqbelow = (int)__builtin_amdgcn_mbcnt_hi((unsigned)(meq >> 32), __builtin_amdgcn_mbcnt_lo((unsigned)meq, 0u));
        const bool sl = (key > thr) || (key == thr && eqbelow < need);
        const unsigned long long msl = __ballot(sl);
        const int rank = (int)__builtin_amdgcn_mbcnt_hi((unsigned)(msl >> 32), __builtin_amdgcn_mbcnt_lo((unsigned)msl, 0u));
        const float wsum = wave_sum_dpp(sl ? sc : 0.f);
        selbits |= sl ? (1u << t) : 0u; slots |= (unsigned)rank << (4 * t); wt[t] = sc / wsum * 2.5f; cntsel += sl ? 1 : 0;
    }
    unsigned wofs = 0u; if (cntsel > 0) wofs = __hip_atomic_fetch_add(lcnt + e, (unsigned)cntsel, __ATOMIC_RELAXED, __HIP_MEMORY_SCOPE_WORKGROUP);
    __syncthreads();
    if (F.wave == 0) { int eo = e; asm volatile("" : "+v"(eo));
        const unsigned c = lcnt[eo]; unsigned gb = 0u; if (c > 0u) gb = atomicAdd(&cntp[eo], c); lcnt[64 + eo] = gb; }
    __syncthreads();
    unsigned base = lcnt[64 + e] + wofs;
#pragma unroll
    for (int t = 0; t < 8; ++t) if ((selbits >> t) & 1u) { const unsigned pos = base++; const int tok = t0 + t; const int sl_ = (int)((slots >> (4 * t)) & 7u); rtk[e * ECAP + pos] = tok; tw[tok * 8 + sl_] = wt[t]; td[tok * 8 + sl_] = ((unsigned)e << 16) | pos; }
    if (!DRY) {
        u32x4 hv[8][2];
#pragma unroll
        for (int t = 0; t < 8; ++t) { const u32x4* hp = (const u32x4*)(F.H1B + (size_t)(t0 + t) * D) + e * 2; hv[t][0] = hp[0]; hv[t][1] = hp[1]; }
#pragma unroll
        for (int t = 0; t < 8; ++t) { const float sc8 = rstd[t] * H1SCALE; u32x4 o;
#pragma unroll
            for (int h = 0; h < 2; ++h)
#pragma unroll
                for (int d = 0; d < 2; ++d) { const unsigned w0 = hv[t][h][2 * d], w1 = hv[t][h][2 * d + 1];
                    int pk = __builtin_amdgcn_cvt_pk_fp8_f32(__uint_as_float(w0 << 16) * sc8, __uint_as_float(w0 & 0xffff0000u) * sc8, 0, false);
                    pk = __builtin_amdgcn_cvt_pk_fp8_f32(__uint_as_float(w1 << 16) * sc8, __uint_as_float(w1 & 0xffff0000u) * sc8, pk, true); o[2 * h + d] = (unsigned)pk; }
            *(u32x4*)(F.H1F8 + (size_t)(t0 + t) * D + e * 16) = o; }
    }
}

__device__ __forceinline__ const unsigned* expert_offsets(Ctx& F) {
    unsigned* so = (unsigned*)(F.lds + 100 * 1024);
    __syncthreads();
    if (F.tid < 64) { const unsigned c = __hip_atomic_load(&F.ctl[F.tid], __ATOMIC_RELAXED, __HIP_MEMORY_SCOPE_AGENT); unsigned o = c;
#pragma unroll
        for (int d = 1; d < 64; d <<= 1) { const unsigned yo = __shfl_up(o, d); if (F.tid >= d) o += yo; }
        so[128 + F.tid] = c; so[F.tid] = o - c; if (F.tid == NE - 1) so[NE] = o; }
    __syncthreads();
    return so;
}

constexpr int LDS_MOETAB = 136192;
__device__ __forceinline__ const LAS unsigned* moe_table(Ctx& F, unsigned char* lds) {
    LAS unsigned* tab = (LAS unsigned*)(lds + LDS_MOETAB);
    __syncthreads();
    if (F.tid < NE) {
        const unsigned c = __hip_atomic_load(&F.ctl[F.tid], __ATOMIC_RELAXED, __HIP_MEMORY_SCOPE_AGENT), tl = (c + 255u) >> 8; unsigned o = c, p = tl;
#pragma unroll
        for (int d = 1; d < 64; d <<= 1) { const unsigned yo = __shfl_up(o, d), yp = __shfl_up(p, d); if (F.tid >= d) { o += yo; p += yp; } }
        tab[128 + F.tid] = c; tab[F.tid] = o - c; tab[256 + F.tid] = p - tl;
        if (F.tid == NE - 1) { tab[128 + NE] = (unsigned)T; tab[NE] = 131072u; tab[256 + NE] = p; tab[256 + NE + 1] = p + T / 256; } }
    __syncthreads();
    return tab;
}
__device__ __forceinline__ void phase_moe_up(Ctx& F, unsigned char* lds) {
    const LAS unsigned* tab = moe_table(F, lds);
    const int vcu = (F.G % 8 == 0) ? (F.bid % 8) * (F.G / 8) + F.bid / 8 : F.bid;
    pg8::MoeOrder S{tab, 2, vcu, F.G, F.rowtok, (const bf16*)F.W13F8, (size_t)512 * 512, 512, true, PROBE_PHASE == 7 ? 2 : 1, F.ident, (const int*)(F.ctl + 3000)};
    { LAS unsigned* tw = (LAS unsigned*)(lds + LDS_MOETAB); if (F.tid < 64) tw[384 + F.tid] = S.unit_at(F.tid); __syncthreads(); }
    pg8::EpiUpG E{F.ACT8, tab, 1.f / (W13SCALE * H1SCALE), ASCALE};
    pg8::gemm_phase_g<pg8::EpiUpG, pg8::MoeOrder, true, true, true>((LAS unsigned char*)lds, (const bf16*)F.H1F8, 512, S, E);
}
__device__ __forceinline__ void phase_moe_down(Ctx& F, unsigned char* lds) {
    { typedef float f32x4_t __attribute__((ext_vector_type(4))); typedef unsigned u32x2_t __attribute__((ext_vector_type(2)));
      for (int i = F.bid * NTHR + F.tid; i < T * DPLE / 4; i += F.G * NTHR) { const f32x4_t v = ((const f32x4_t*)F.p)[i]; ((u32x2_t*)F.PB)[i] = (u32x2_t){pk2(v[0], v[1]), pk2(v[2], v[3])}; } }
    const LAS unsigned* tab = moe_table(F, lds);
    const int vcu = (F.G % 8 == 0) ? (F.bid % 8) * (F.G / 8) + F.bid / 8 : F.bid;
    pg8::MoeOrder S{tab, 4, vcu, F.G, nullptr, (const bf16*)F.W2F8, (size_t)1024 * 128, 128, false, PROBE_PHASE == 8 ? 2 : 1, nullptr, nullptr};
    { LAS unsigned* tw = (LAS unsigned*)(lds + LDS_MOETAB); if (F.tid < 64) tw[384 + F.tid] = S.unit_at(F.tid); __syncthreads(); }
    pg8::EpiDownG E{F.YB, F.out, tab, YSCALE / (ASCALE * W2SCALE)};
    pg8::gemm_phase_g<pg8::EpiDownG, pg8::MoeOrder, false, false, true>((LAS unsigned char*)lds, (const bf16*)F.ACT8, 128, S, E);
}
template <bool DRY>
__device__ __forceinline__ void phase_combine(Ctx& F, unsigned char* lds) {
    const unsigned* so = expert_offsets(F);
    const int gw = (F.G == 256 ? F.vcu : F.bid) * NWAVES + F.wave, NGW = F.G * NWAVES;
    typedef float f32x4_t __attribute__((ext_vector_type(4))); typedef float f32x2_t __attribute__((ext_vector_type(2)));
    for (int t8 = gw * 8; t8 < T; t8 += NGW * 8) {
        typedef unsigned u32x2_t __attribute__((ext_vector_type(2)));
        const unsigned dd = F.topd[t8 * 8 + F.lane]; const float wl = F.topw[t8 * 8 + F.lane] * (1.f / YSCALE); const unsigned rowl = so[dd >> 16] + (dd & 0xffffu);
#pragma unroll 2
        for (int tt = 0; tt < 8; ++tt) { const int t = t8 + tt;
            pg8::f32x4 h[4];
            u32x2_t y0[9], y1[9]; float w[9];
#pragma unroll
            for (int k = 0; k < 9; ++k) { size_t row;
                if (k < 8) { row = (size_t)(unsigned)__builtin_amdgcn_readlane((int)rowl, tt * 8 + k); w[k] = bcast_lane(wl, tt * 8 + k); } else { row = (size_t)131072 + t; w[k] = 1.f / YSCALE; }
                const u32x2_t* yp = (const u32x2_t*)(F.YB + row * D) + F.lane; y0[k] = yp[0]; y1[k] = yp[64]; }
            { const u32x4* hp = (const u32x4*)(F.H1B + (size_t)t * D) + F.lane; pg8::unpack8(hp[0], h[0], h[1]); pg8::unpack8(hp[64], h[2], h[3]); }
#pragma unroll
            for (int k = 0; k < 9; ++k) { const unsigned yy[4] = {y0[k].x, y0[k].y, y1[k].x, y1[k].y};
#pragma unroll
                for (int q = 0; q < 4; ++q) { const f32x2_t lo = __builtin_amdgcn_cvt_pk_f32_fp8((int)yy[q], false), hi = __builtin_amdgcn_cvt_pk_f32_fp8((int)yy[q], true);
                    h[q][0] += w[k] * lo[0]; h[q][1] += w[k] * lo[1]; h[q][2] += w[k] * hi[0]; h[q][3] += w[k] * hi[1]; } }
            float ssq = 0.f;
#pragma unroll
            for (int q = 0; q < 4; ++q) ssq += h[q][0] * h[q][0] + h[q][1] * h[q][1] + h[q][2] * h[q][2] + h[q][3] * h[q][3];
            u32x4* hb = (u32x4*)(F.H2B + (size_t)t * D) + F.lane; hb[0] = pg8::pack8(h[0], h[1]); hb[64] = pg8::pack8(h[2], h[3]);
            const float rstd = rsqrtf(wave_sum(ssq) * (1.f / D) + EPS);
            { const float s8 = rstd * H2SCALE; u32x2_t o0, o1;
              int pk = __builtin_amdgcn_cvt_pk_fp8_f32(h[0][0] * s8, h[0][1] * s8, 0, false); pk = __builtin_amdgcn_cvt_pk_fp8_f32(h[0][2] * s8, h[0][3] * s8, pk, true); o0.x = (unsigned)pk;
              pk = __builtin_amdgcn_cvt_pk_fp8_f32(h[1][0] * s8, h[1][1] * s8, 0, false); pk = __builtin_amdgcn_cvt_pk_fp8_f32(h[1][2] * s8, h[1][3] * s8, pk, true); o0.y = (unsigned)pk;
              pk = __builtin_amdgcn_cvt_pk_fp8_f32(h[2][0] * s8, h[2][1] * s8, 0, false); pk = __builtin_amdgcn_cvt_pk_fp8_f32(h[2][2] * s8, h[2][3] * s8, pk, true); o1.x = (unsigned)pk;
              pk = __builtin_amdgcn_cvt_pk_fp8_f32(h[3][0] * s8, h[3][1] * s8, 0, false); pk = __builtin_amdgcn_cvt_pk_fp8_f32(h[3][2] * s8, h[3][3] * s8, pk, true); o1.y = (unsigned)pk;
              u32x2_t* h8 = (u32x2_t*)(F.H2F8 + (size_t)t * D) + F.lane; h8[0] = o0; h8[64] = o1; }
            if (F.lane == 0) F.rstd2[t] = rstd; }
    }
    __syncthreads();
    if (!DRY) {
        pg8::Gemm g{F.PB, F.WppT, T, D, DPLE}; pg8::EpiStoreBf16 E{F.Gt};
        if (F.G == 256) { pg8::PanelOrder S{F.vcu}; pg8::gemm_phase<pg8::EpiStoreBf16, pg8::PanelOrder, true, true>((LAS unsigned char*)lds, g, S, E); }
        else { pg8::StaticOrder S; S.init(T, D, F.G, F.bid); pg8::gemm_phase<pg8::EpiStoreBf16, pg8::StaticOrder, true, true>((LAS unsigned char*)lds, g, S, E); }
    }
}
__device__ __forceinline__ void phase_gate(Ctx& F) {
    constexpr float cs = 1.f / (H2SCALE * WPGSCALE);
    pg8::Gemm g{(const bf16*)F.H2F8, F.WpgT, T, D, D / 2}; pg8::EpiGateFused E{F.H3B, F.H2B, F.Gt, cs};
    if (F.G == 256) { pg8::PanelOrder S{F.vcu}; pg8::EpiGateFinal EF{F.out, F.H2B, F.Gt, cs, F.ln_f, (float*)(F.ws + WS_XS), F.ctl};
        pg8::gemm_phase<pg8::EpiGateFinal, pg8::PanelOrder, true, true, true>((LAS unsigned char*)F.lds, g, S, EF); }
    else { pg8::StaticOrder S; S.init(T, D, F.G, F.bid); pg8::gemm_phase<pg8::EpiGateFused, pg8::StaticOrder, true, true, true>((LAS unsigned char*)F.lds, g, S, E); }
}
template <bool DRY>
__device__ __forceinline__ void phase_final(Ctx& F) {
    typedef float f32x4_t __attribute__((ext_vector_type(4))); typedef unsigned u32x2_t __attribute__((ext_vector_type(2)));
    const int gw = (F.G == 256 ? F.vcu : F.bid) * NWAVES + F.wave, NGW = F.G * NWAVES;
    f32x4_t g[4];
#pragma unroll
    for (int q = 0; q < 4; ++q) g[q] = ((const f32x4_t*)F.ln_f)[q * 64 + F.lane];
    for (int r8 = gw * 8; r8 < T; r8 += NGW * 8)
    for (int row = r8; row < r8 + 8; ++row) {
        const u32x2_t* hp = (const u32x2_t*)(F.H3B + (size_t)row * D) + F.lane; f32x4_t h[4]; float s = 0.f;
#pragma unroll
        for (int q = 0; q < 4; ++q) { const u32x2_t w = hp[q * 64]; h[q][0] = __uint_as_float(w.x << 16); h[q][1] = __uint_as_float(w.x & 0xffff0000u); h[q][2] = __uint_as_float(w.y << 16); h[q][3] = __uint_as_float(w.y & 0xffff0000u);
            s += h[q][0] * h[q][0] + h[q][1] * h[q][1] + h[q][2] * h[q][2] + h[q][3] * h[q][3]; }
        const float rstd = rsqrtf(wave_sum(s) * (1.f / D) + EPS);
        f32x4_t* op = (f32x4_t*)(F.out + (size_t)row * D) + F.lane;
#pragma unroll
        for (int q = 0; q < 4; ++q) op[q * 64] = h[q] * rstd * g[q];
    }
}

constexpr int NPHASE = 13;
__global__ void __launch_bounds__(NTHR, 2) mk_fwd(Args args) {
    extern __shared__ __attribute__((aligned(16))) unsigned char lds[];
    Ctx F;
    F.lds = lds; F.tid = threadIdx.x; F.lane = F.tid & 63; F.wave = __builtin_amdgcn_readfirstlane(F.tid >> 6); F.bid = blockIdx.x; F.G = gridDim.x; F.vcu = (F.G % 8 == 0) ? (F.bid % 8) * (F.G / 8) + F.bid / 8 : F.bid;
    const void* const* in = args.in;
    F.x = (const float*)in[0]; F.p = (const float*)in[1]; F.positions = (const int*)in[2]; F.ln_mix = (const float*)in[3]; F.w_in = (const float*)in[4]; F.conv_w = (const float*)in[5]; F.conv_b = (const float*)in[6];
    F.w_a = (const float*)in[7]; F.b_a = (const float*)in[8]; F.w_i = (const float*)in[9]; F.b_i = (const float*)in[10]; F.rg_lambda = (const float*)in[11]; F.g_rec = (const float*)in[12];
    F.lq1 = (const float*)in[13]; F.lk1 = (const float*)in[14]; F.lq2 = (const float*)in[15]; F.lk2 = (const float*)in[16]; F.g_sub = (const float*)in[17]; F.w_out = (const float*)in[18];
    F.ln_moe = (const float*)in[19]; F.w_router = (const float*)in[20]; F.e_bias = (const float*)in[21]; F.w1 = (const float*)in[22]; F.w3 = (const float*)in[23]; F.w2 = (const float*)in[24];
    F.ws1 = (const float*)in[25]; F.ws3 = (const float*)in[26]; F.ws2 = (const float*)in[27]; F.ln_ple = (const float*)in[28]; F.w_pg = (const float*)in[29]; F.w_pp = (const float*)in[30]; F.ln_f = (const float*)in[31];
    F.out = args.out; unsigned char* ws = args.ws; F.ws = ws;
    F.ctl = (unsigned*)(ws + WS_CTL); F.rstd1 = (float*)(ws + WS_RSTD1); F.rstd2 = (float*)(ws + WS_RSTD2); F.rope = (float*)(ws + WS_ROPE); F.WrT = (bf16*)(ws + WS_WR); F.ident = (int*)(ws + WS_IDENT); F.rx = (float*)(ws + WS_RX); F.WgT = (bf16*)(ws + WS_WG); F.lau = (unsigned*)(ws + WS_LAU); F.sum = (float*)(ws + WS_SUM);
    F.topw = (float*)(ws + WS_TOPW); F.topd = (unsigned*)(ws + WS_TOPD); F.rowtok = (int*)(ws + WS_ROWTOK);
    F.WoutT = (bf16*)(ws + WS_WOUT); F.WpgT = (bf16*)(ws + WS_WPG); F.WppT = (bf16*)(ws + WS_WPP); F.WinT = (bf16*)(ws + WS_WIN); F.W2T = (bf16*)(ws + WS_W2); F.W13T = (bf16*)(ws + WS_W13); F.W13F8 = ws + WS_W13; F.W2F8 = ws + WS_W2; F.ACT8 = ws + WS_ACT; F.H2F8 = ws + WS_H2F8; F.H1F8 = (unsigned char*)args.out + 32 * MiB;     F.H3B = (bf16*)(ws + WS_H3B);
    F.XB = (bf16*)(ws + WS_XB); F.MIX = (bf16*)(ws + WS_MIX); F.ZA = (bf16*)(ws + WS_ZA); F.H1B = (bf16*)args.out;     F.Q = (bf16*)(ws + WS_Q); F.K = (bf16*)(ws + WS_K); F.V = (bf16*)(ws + WS_V); F.O = (bf16*)(ws + WS_O);
    F.ACT = (bf16*)(ws + WS_ACT); F.YB = ws + WS_YB; F.H2B = (bf16*)(ws + WS_H2B); F.PB = (bf16*)(ws + WS_PB); F.Gt = (bf16*)(ws + WS_G);

    for (int u = F.tid; u < (LDS_BYTES - LDSCTL_OFF) / 4; u += NTHR) ((unsigned*)(lds + LDSCTL_OFF))[u] = 0u;
    __syncthreads();
    if (F.lane == 0) ((volatile unsigned*)(lds + LDSCTL_OFF))[hw_slot()] = (unsigned)F.wave;
    __syncthreads();
    const bool one_launch = (args.ph_lo == 0 && args.ph_hi == NPHASE);
    XcdBarrier bar; bar.bar = F.ctl + CW_BAR; bar.x = 0; bar.st = nullptr;
    if (args.ph_hi - args.ph_lo > 1) bar = xcd_barrier_post(F.ctl + CW_BAR, (volatile LAS unsigned*)(lds + MISC_OFF + 32));
    (void)one_launch;
    const int lo = args.ph_lo, hi = args.ph_hi;
#define IN(k) (lo <= (k) && (k) < hi)
#define REP(k, body) do { body; if ((k) == PROBE_PHASE) { body; } } while (0)
#define REFRESH() do { F.tid = opaque_tid(); F.lane = F.tid & 63; } while (0)
#define SEAM(k) do { if (IN(k) && IN((k) + 1)) xcd_barrier(bar); } while (0)
#define PSEAM(k, st) do { if (IN(k) && IN((k) + 1)) { if (F.G == 256) panel_barrier(F.ctl, st, F.vcu >> 2); else xcd_barrier(bar); } } while (0)
    const int gw = F.bid * NWAVES + F.wave, NGW = F.G * NWAVES;

    REFRESH(); if (IN(0)) { REP(0, phase_prologue(F); __syncthreads()); } SEAM(0);
    REFRESH(); if (IN(1)) { REP(1, phase_gemm1(F)); } SEAM(1);
      if (IN(2)) {}
#define PH3_BODY() do { for (int unit = F.bid; unit < NBATCH * NCHUNK; unit += F.G) rglru_pass0_mfma(F, unit, lds); \
        __syncthreads(); \
        { const attn_body::AttnTensors AT{(const attn_body::bf16*)F.Q, (const attn_body::bf16*)F.K, (const attn_body::bf16*)F.V, (attn_body::bf16*)F.O}; \
          const attn_body::StaticOrder SA(F.G, F.bid); \
          attn_body::attn_phase<attn_body::StaticOrder>((char*)lds, AT, SA); } } while (0)
#define PH4_BODY() do { const int ub = (F.G == 256) ? F.vcu : F.bid; for (int unit = ub; unit < NBATCH * NCHUNK; unit += F.G) rglru_pass1(F, unit); \
        for (int r8 = (ub * NWAVES + F.wave) * 8; r8 < T; r8 += NGW * 8) for (int row = r8; row < r8 + 8; ++row) attmix_row(F, row); } while (0)
    REFRESH(); if (IN(3)) { REP(3, PH3_BODY()); } SEAM(3);
    REFRESH(); if (IN(4)) { REP(4, PH4_BODY()); } PSEAM(4, 0);
    REFRESH(); if (IN(5)) { REP(5, phase_wout(F)); } PSEAM(5, 1);
    REFRESH(); if (IN(6)) { if (PROBE_PHASE == 6) { for (int tb = (F.G == 256 ? F.vcu : F.bid); tb < T / 64; tb += F.G) router_block<true>(F, tb, lds); } for (int tb = (F.G == 256 ? F.vcu : F.bid); tb < T / 64; tb += F.G) router_block<false>(F, tb, lds); } SEAM(6);
    REFRESH(); if (IN(7)) { phase_moe_up(F, lds); } SEAM(7);
    REFRESH(); if (IN(8)) { phase_moe_down(F, lds); } SEAM(8);
    REFRESH(); if (IN(9)) { if (PROBE_PHASE == 9) phase_combine<true>(F, lds); phase_combine<false>(F, lds); } SEAM(9);
    REFRESH(); if (IN(10)) { REP(10, phase_gate(F)); } if (IN(10) && IN(12) && F.G != 256) xcd_barrier(bar);
    REFRESH(); if (IN(12) && F.G != 256) { REP(12, phase_final<false>(F)); }
#undef IN
#undef SEAM
}

#ifndef MK_N_LAUNCHES
#define MK_N_LAUNCHES 1
#endif
extern "C" void kernel_launch(void* const* d_in, const int* in_sizes, int n_in, void* d_out, int out_size, void* d_ws, size_t ws_size, hipStream_t stream) {
    static int grid = 0;
    if (grid == 0) {
        if (n_in != 32 || ws_size < WS_END || out_size != T * D) { grid = -1; return; }
        int dev = 0, cus = 0;
        if (hipGetDevice(&dev) != hipSuccess || hipDeviceGetAttribute(&cus, hipDeviceAttributeMultiprocessorCount, dev) != hipSuccess) { grid = -1; return; }
        if (hipFuncSetAttribute((const void*)mk_fwd, hipFuncAttributeMaxDynamicSharedMemorySize, LDS_BYTES) != hipSuccess) { grid = -1; return; }
        int per_cu = 0; (void)hipOccupancyMaxActiveBlocksPerMultiprocessor(&per_cu, (const void*)mk_fwd, NTHR, LDS_BYTES); (void)hipGetLastError();
        grid = cus;
    }
    if (grid < 0) return;
    (void)hipMemsetAsync((char*)d_ws + WS_CTL, 0, CTL_ZERO_BYTES, stream);
    Args a{};
    for (int i = 0; i < 32; ++i) a.in[i] = d_in[i];
    a.out = (float*)d_out; a.ws = (unsigned char*)d_ws;
    if (MK_N_LAUNCHES == 1) { a.ph_lo = 0; a.ph_hi = NPHASE; hipLaunchKernelGGL(mk_fwd, dim3(grid), dim3(NTHR), LDS_BYTES, stream, a); }
    else { for (int ph = 0; ph < NPHASE; ++ph) { a.ph_lo = ph; a.ph_hi = ph + 1; hipLaunchKernelGGL(mk_fwd, dim3(grid), dim3(NTHR), LDS_BYTES, stream, a); } }
}
```
